# Optimizing an MI355X kernel written in HIP

```python
import jax, jax.numpy as jnp
from jax import lax
import numpy as np

D_MODEL = 1024
BATCH = 2
SEQ = 8192
DEPTH = 1
DEC_BATCH = 128
DEC_SEQ = 4
PAST_LEN = 8192
PAGE_SIZE = 128

M_HEADS = 4
M_DK = 128
M_DV = 128
M_WIDTH = M_HEADS * M_DV
MLSTM_CHUNK = 64
A_HEADS = 8
A_KV_HEADS = 2
A_HD = 64
A_GROUP = A_HEADS // A_KV_HEADS
A_WIDTH = A_HEADS * A_HD
WINDOW = 128
D_MIX = M_WIDTH + A_WIDTH
SPLITS = (M_HEADS * M_DK, M_HEADS * M_DK, M_WIDTH, M_WIDTH, M_HEADS, M_HEADS,
          A_WIDTH, A_KV_HEADS * A_HD, A_KV_HEADS * A_HD)
D_IN = 2 * M_HEADS * M_DK + 2 * M_WIDTH + 2 * M_HEADS + A_WIDTH + 2 * A_KV_HEADS * A_HD
D_FF = 2816
RMS_EPS = 1e-6

kernel_name = "hymba_mlstm_swa_sink_alibi_macaron_step"


def rmsnorm(x, g):
    xf = x.astype(jnp.float32)
    y = xf * lax.rsqrt(jnp.mean(xf * xf, axis=-1, keepdims=True) + RMS_EPS)
    return (y * g.astype(jnp.float32)).astype(x.dtype)


def swiglu(x, w_gate, w_up, w_down):
    return (jax.nn.silu(x @ w_gate) * (x @ w_up)) @ w_down


def split_proj(h, w_in, b_gate):
    B, T, _ = h.shape
    z = h @ w_in
    idx = np.cumsum(SPLITS)[:-1].tolist()
    qm, km, vm, om, ip, fp, qa, ka, va = jnp.split(z, idx, axis=-1)
    bg = b_gate.astype(z.dtype)
    m_parts = (qm.reshape(B, T, M_HEADS, M_DK),
               km.reshape(B, T, M_HEADS, M_DK) * (M_DK ** -0.5),
               vm.reshape(B, T, M_HEADS, M_DV),
               jax.nn.sigmoid(om.astype(jnp.float32)),
               ip + bg[:M_HEADS],
               fp + bg[M_HEADS:])
    a_parts = (qa.reshape(B, T, A_HEADS, A_HD),
               ka.reshape(B, T, A_KV_HEADS, A_HD),
               va.reshape(B, T, A_KV_HEADS, A_HD))
    return m_parts, a_parts


def mlstm_chunk(carry, xs):
    C, n, m = carry
    q, k, v, ig, fg = xs
    L = q.shape[2]
    b = jnp.cumsum(jax.nn.log_sigmoid(fg), axis=-1)
    causal = jnp.tril(jnp.ones((L, L), dtype=bool))
    D = jnp.where(causal, b[..., :, None] - b[..., None, :] + ig[..., None, :], -jnp.inf)
    inter = b + m[..., None]
    m_t = jnp.maximum(inter, jnp.max(D, axis=-1))
    W = jnp.exp(D - m_t[..., None])
    a = jnp.exp(inter - m_t)
    S = jnp.einsum('bhtd,bhsd->bhts', q, k) * W
    num = a[..., None] * jnp.einsum('bhtk,bhkv->bhtv', q, C) + jnp.einsum('bhts,bhsv->bhtv', S, v)
    den = a * jnp.einsum('bhtk,bhk->bht', q, n) + jnp.sum(S, axis=-1)
    h = num / jnp.maximum(jnp.abs(den), jnp.exp(-m_t))[..., None]
    bL = b[..., -1]
    g = bL[..., None] - b + ig
    m_new = jnp.maximum(bL + m, jnp.max(g, axis=-1))
    decay = jnp.exp(bL + m - m_new)
    wk = jnp.exp(g - m_new[..., None])
    C_new = decay[..., None, None] * C + jnp.einsum('bhs,bhsk,bhsv->bhkv', wk, k, v)
    n_new = decay[..., None] * n + jnp.einsum('bhs,bhsk->bhk', wk, k)
    return (C_new, n_new, m_new), h


def mlstm_heads(q, k, v, o, ig, fg, state, norm_gain, out_dtype):
    B, T = q.shape[:2]
    L = MLSTM_CHUNK if T % MLSTM_CHUNK == 0 else T
    nc = T // L

    def chunks(a):
        a = a.astype(jnp.float32).reshape((B, nc, L) + a.shape[2:])
        return jnp.moveaxis(a, (1, 3), (0, 2))

    C0, n0, m0 = state
    init = (C0.astype(jnp.float32), n0.astype(jnp.float32), m0.astype(jnp.float32))
    (C1, n1, m1), h = lax.scan(mlstm_chunk, init,
                               (chunks(q), chunks(k), chunks(v), chunks(ig), chunks(fg)))
    h = jnp.moveaxis(h, (0, 2), (1, 3)).reshape(B, T, M_HEADS, M_DV)
    h = h * lax.rsqrt(jnp.mean(h * h, axis=-1, keepdims=True) + RMS_EPS)
    h = h * norm_gain.astype(jnp.float32).reshape(M_HEADS, M_DV)
    h = o.reshape(B, T, M_HEADS, M_DV) * h
    return h.reshape(B, T, M_WIDTH).astype(out_dtype), (C1, n1, m1)


def alibi(dist):
    slopes = jnp.exp2(-8.0 * jnp.arange(1, A_HEADS + 1, dtype=jnp.float32) / A_HEADS)
    slopes = slopes.reshape(A_KV_HEADS, A_GROUP)
    return -slopes[:, :, None, None] * dist.astype(jnp.float32)


def sink_softmax(s, sinks):
    sk = sinks.astype(jnp.float32).reshape(A_KV_HEADS, A_GROUP, 1)
    mx = jnp.maximum(jnp.max(s, axis=-1), sk)
    p = jnp.exp(s - mx[..., None])
    den = jnp.sum(p, axis=-1) + jnp.exp(sk - mx)
    return p / den[..., None]


def swa_prompt(q, k, v, sinks):
    B, T = q.shape[:2]
    nb = T // WINDOW
    qb = q.reshape(B, nb, WINDOW, A_KV_HEADS, A_GROUP, A_HD)
    kb = k.reshape(B, nb, WINDOW, A_KV_HEADS, A_HD)
    vb = v.reshape(B, nb, WINDOW, A_KV_HEADS, A_HD)
    shift = lambda a: jnp.concatenate([jnp.zeros_like(a[:, :1]), a[:, :-1]], axis=1)
    kk = jnp.concatenate([shift(kb), kb], axis=2)
    vv = jnp.concatenate([shift(vb), vb], axis=2)
    qi = jnp.arange(WINDOW)[:, None]
    kj = jnp.arange(2 * WINDOW)[None, :]
    dist = WINDOW + qi - kj
    exists = (jnp.arange(nb)[:, None, None] * WINDOW + kj - WINDOW) >= 0
    valid = (dist >= 0) & (dist < WINDOW) & exists
    s = jnp.einsum('bnqhgd,bnkhd->bnhgqk', qb, kk).astype(jnp.float32) * (A_HD ** -0.5) + alibi(dist)
    s = jnp.where(valid[None, :, None, None], s, -jnp.inf)
    p = sink_softmax(s, sinks)
    o = jnp.einsum('bnhgqk,bnkhd->bnqhgd', p.astype(v.dtype), vv).reshape(B, T, A_WIDTH)
    keep = min(WINDOW, T)
    return o, (k[:, T - keep:], v[:, T - keep:])


def swa_sample(q, k, v, sinks, buf_k, buf_v):
    Bd, S = q.shape[:2]
    Wc = buf_k.shape[1]
    kk = jnp.concatenate([buf_k.astype(k.dtype), k], axis=1)
    vv = jnp.concatenate([buf_v.astype(v.dtype), v], axis=1)
    dist = Wc + jnp.arange(S)[:, None] - jnp.arange(Wc + S)[None, :]
    valid = (dist >= 0) & (dist < WINDOW)
    qg = q.reshape(Bd, S, A_KV_HEADS, A_GROUP, A_HD)
    s = jnp.einsum('bqhgd,bkhd->bhgqk', qg, kk).astype(jnp.float32) * (A_HD ** -0.5) + alibi(dist)
    s = jnp.where(valid, s, -jnp.inf)
    p = sink_softmax(s, sinks)
    o = jnp.einsum('bhgqk,bkhd->bqhgd', p.astype(v.dtype), vv).reshape(Bd, S, A_WIDTH)
    return o, (kk[:, S:], vv[:, S:])


def trunk_layer(x, l, mstate, kv_buf, norm_gains, ffn_w_gate, ffn_w_up, ffn_w_down,
                w_in, b_gate, mlstm_norm_gain, attn_sinks, w_out):
    g = norm_gains[l]

    def half_ffn(x, j, gpre, gpost):
        y = swiglu(rmsnorm(x, g[gpre]), ffn_w_gate[l, j], ffn_w_up[l, j], ffn_w_down[l, j])
        return x + 0.5 * rmsnorm(y, g[gpost])

    x = half_ffn(x, 0, 0, 1)
    h = rmsnorm(x, g[2])
    (qm, km, vm, om, ip, fp), (qa, ka, va) = split_proj(h, w_in[l], b_gate[l])
    u_m, new_m = mlstm_heads(qm, km, vm, om, ip, fp, mstate, mlstm_norm_gain[l], h.dtype)
    if kv_buf is None:
        u_a, new_kv = swa_prompt(qa, ka, va, attn_sinks[l])
    else:
        u_a, new_kv = swa_sample(qa, ka, va, attn_sinks[l], kv_buf[0], kv_buf[1])
    u = jnp.concatenate([u_m, u_a], axis=-1)
    x = x + rmsnorm(u @ w_out[l], g[3])
    x = half_ffn(x, 1, 4, 5)
    return x, (new_kv[0], new_kv[1], new_m[0], new_m[1], new_m[2])


def setup_inputs(seed: int = 0) -> dict:
    key = jax.random.key(seed)
    ks = jax.random.split(key, 20)
    f32 = jnp.float32
    nrm = lambda k, shape, scale: scale * jax.random.normal(k, shape, f32)
    w_cache = min(WINDOW, PAST_LEN)
    b_gate = jnp.concatenate(
        [nrm(ks[0], (DEPTH, M_HEADS), 0.1),
         jnp.linspace(3.0, 6.0, M_HEADS, dtype=f32)[None, :] + nrm(ks[1], (DEPTH, M_HEADS), 0.1)], axis=-1)
    return {
        "x_prompt": nrm(ks[2], (BATCH, SEQ, D_MODEL), 1.0),
        "x_sample": nrm(ks[3], (DEC_BATCH, DEC_SEQ, D_MODEL), 1.0),
        "cache_swa_k": nrm(ks[4], (DEPTH, DEC_BATCH, w_cache, A_KV_HEADS, A_HD), 1.0),
        "cache_swa_v": nrm(ks[5], (DEPTH, DEC_BATCH, w_cache, A_KV_HEADS, A_HD), 1.0),
        "state_mlstm_C": nrm(ks[6], (DEPTH, DEC_BATCH, M_HEADS, M_DK, M_DV), 0.3),
        "state_mlstm_n": nrm(ks[7], (DEPTH, DEC_BATCH, M_HEADS, M_DK), 0.3),
        "state_mlstm_m": nrm(ks[8], (DEPTH, DEC_BATCH, M_HEADS), 1.0),
        "norm_gains": 1.0 + nrm(ks[9], (DEPTH, 6, D_MODEL), 0.05),
        "ffn_w_gate": nrm(ks[10], (DEPTH, 2, D_MODEL, D_FF), D_MODEL ** -0.5),
        "ffn_w_up": nrm(ks[11], (DEPTH, 2, D_MODEL, D_FF), D_MODEL ** -0.5),
        "ffn_w_down": nrm(ks[12], (DEPTH, 2, D_FF, D_MODEL), D_FF ** -0.5),
        "w_in": nrm(ks[13], (DEPTH, D_MODEL, D_IN), D_MODEL ** -0.5),
        "b_gate": b_gate,
        "mlstm_norm_gain": 1.0 + nrm(ks[14], (DEPTH, M_WIDTH), 0.05),
        "attn_sinks": nrm(ks[15], (DEPTH, A_HEADS), 1.0),
        "w_out": nrm(ks[16], (DEPTH, D_MIX, D_MODEL), D_MIX ** -0.5),
    }


def reference(x_prompt, x_sample, cache_swa_k, cache_swa_v, state_mlstm_C, state_mlstm_n,
              state_mlstm_m, norm_gains, ffn_w_gate, ffn_w_up, ffn_w_down, w_in, b_gate,
              mlstm_norm_gain, attn_sinks, w_out):
    B = x_prompt.shape[0]
    zero_state = (jnp.zeros((B, M_HEADS, M_DK, M_DV), jnp.float32),
                  jnp.zeros((B, M_HEADS, M_DK), jnp.float32),
                  jnp.zeros((B, M_HEADS), jnp.float32))
    yp, ys = x_prompt, x_sample
    p_new, s_new = [], []
    for l in range(DEPTH):
        yp, st_p = trunk_layer(yp, l, zero_state, None, norm_gains, ffn_w_gate, ffn_w_up,
                               ffn_w_down, w_in, b_gate, mlstm_norm_gain, attn_sinks, w_out)
        p_new.append(st_p)
        ys, st_s = trunk_layer(ys, l, (state_mlstm_C[l], state_mlstm_n[l], state_mlstm_m[l]),
                               (cache_swa_k[l], cache_swa_v[l]), norm_gains, ffn_w_gate, ffn_w_up,
                               ffn_w_down, w_in, b_gate, mlstm_norm_gain, attn_sinks, w_out)
        s_new.append(st_s)
    stk = lambda lst, i: jnp.stack([st[i] for st in lst], axis=0)
    return (yp, ys,
            stk(p_new, 0), stk(p_new, 1), stk(p_new, 2), stk(p_new, 3), stk(p_new, 4),
            stk(s_new, 0), stk(s_new, 1), stk(s_new, 2), stk(s_new, 3), stk(s_new, 4))
```

```cpp
#include <hip/hip_runtime.h>
#include <hip/hip_cooperative_groups.h>
#include <cstdio>
#include <cstdint>
namespace cg = cooperative_groups;
__device__ __forceinline__ int tid_fresh() { int t = threadIdx.x; asm volatile("" : "+v"(t)); return t; }
namespace pg8 {
#define PG8_LAS __attribute__((address_space(3)))
typedef unsigned short bf16_t;
typedef short bf16x8 __attribute__((ext_vector_type(8)));
typedef float f32x4 __attribute__((ext_vector_type(4)));
typedef unsigned u32x4 __attribute__((ext_vector_type(4)));
constexpr int BM = 256, BK = 64, HALF = 128, HTB = HALF * BK * 2  , STAGE_BYTES = 8 * HTB, NXCD = 8, WGM = 8;

__host__ __device__ __forceinline__ int lds_byte(int r, int c) { const int st = (r >> 4) * 2 + (c >> 5), rr = r & 15, cc = c & 31, ob = rr * 64 + cc * 2; return st * 1024 + (ob ^ (((ob >> 9) & 1) << 5)); }
__host__ __device__ __forceinline__ void stage_rc(int b, int& R, int& C) { const int st = b / 1024, sb = b % 1024, swz = sb ^ (((sb >> 9) & 1) << 5); R = (st >> 1) * 16 + swz / 64; C = (st & 1) * 32 + (swz % 64) / 2; }
__host__ __device__ __forceinline__ int perm32(int rho) { const int n = rho >> 4, i = rho & 15; return 8 * (i >> 2) + 4 * n + (i & 3); }

struct Unit { int pm, pn; };
struct Gemm { const bf16_t* A; const bf16_t* Bt; int M, N, K; };

struct StaticOrder {
    int nM, nN, nwg, G, c;
    __host__ __device__ void init(int M, int N, int G_, int c_) { nM = M / BM; nN = N / BM; nwg = nM * nN; G = G_; c = c_; }
    __host__ __device__ bool next(int i, Unit& u) const {
        const long L = (long)i * G + c; if (L >= nwg) return false;
        int wgid = (int)L; { const int q = nwg / NXCD, r = nwg % NXCD, xcd = wgid % NXCD, off = wgid / NXCD; wgid = (xcd < r ? xcd * (q + 1) : r * (q + 1) + (xcd - r) * q) + off; }
        const int nig = WGM * nN, gid = wgid / nig, fm = gid * WGM, gsz = (nM - fm) < WGM ? (nM - fm) : WGM;
        u.pm = fm + ((wgid % nig) % gsz); u.pn = (wgid % nig) / gsz; return true;
    }
    __device__ __forceinline__ void a_ready(const Unit&) const {}
    __device__ __forceinline__ void done(const Unit&) const {}
};

__device__ __forceinline__ unsigned cvt_pk_bf16(float lo, float hi) { unsigned r; asm volatile("v_cvt_pk_bf16_f32 %0, %1, %2" : "=v"(r) : "v"(lo), "v"(hi)); return r; }
typedef float f32x2 __attribute__((ext_vector_type(2)));
__device__ __forceinline__ f32x2 gelu_pk(f32x2 v) {
    const f32x2 av = __builtin_elementwise_abs(v), d = av * 0.2316418882f + 1.0f;
    f32x2 t; t.x = __builtin_amdgcn_rcpf(d.x); t.y = __builtin_amdgcn_rcpf(d.y);
    f32x2 q = t * 0.5307027145f + (-0.7265760135f); q = q * t + 0.7107068705f; q = q * t + (-0.142248368f); q = q * t + 0.127414796f; q = q * t;
    const f32x2 s = (v * v) * (-0.72134752044f);
    f32x2 e; e.x = __builtin_amdgcn_exp2f(s.x); e.y = __builtin_amdgcn_exp2f(s.y);
    const f32x2 m = v * (q * e), r = v - m;
    f32x2 o; o.x = v.x < 0.f ? m.x : r.x; o.y = v.y < 0.f ? m.y : r.y; return o;
}

template <int ACT  > struct EpiBf16 {
    static constexpr bool PERM = true, AFTER_DRAIN = false; static_assert(ACT == 0 || ACT == 1, "EpiBf16: ACT is 0 (none) or 1 (gelu_pk)");
    bf16_t* O; int ldc; const float* bias; int split_cols; size_t split_stride; float scale0;
    __device__ __forceinline__ void operator()(const f32x4 (&acc)[2][2][4][2], const Unit& u, int wr, int wc, int fr, int fq) const {
        const int row0 = u.pm * BM + wr * 64 + fr; int colt = u.pn * BM; bf16_t* base = O;
        float sc = 1.f; if (split_cols) { const int t = colt / split_cols; base += (size_t)t * split_stride; colt -= t * split_cols; if (t == 0) sc = scale0; }
        const int col0 = colt + wc * 32 + 8 * fq, bcol0 = u.pn * BM + wc * 32 + 8 * fq;
        f32x4 bv[2][2];
#pragma unroll
        for (int bj = 0; bj < 2; ++bj)
#pragma unroll
            for (int n = 0; n < 2; ++n) bv[bj][n] = bias ? *(const f32x4*)(bias + bcol0 + bj * HALF + 4 * n) : (f32x4){0.f, 0.f, 0.f, 0.f};
#pragma unroll
        for (int ai = 0; ai < 2; ++ai)
#pragma unroll
            for (int m = 0; m < 4; ++m) { bf16_t* rowp = base + (size_t)(row0 + ai * HALF + m * 16) * ldc + col0;
#pragma unroll
                for (int bj = 0; bj < 2; ++bj) { f32x4 v0 = acc[ai][bj][m][0] + bv[bj][0], v1 = acc[ai][bj][m][1] + bv[bj][1];
                    if (ACT == 1) { f32x2 a = gelu_pk((f32x2){v0[0], v0[1]}), b = gelu_pk((f32x2){v0[2], v0[3]}), c = gelu_pk((f32x2){v1[0], v1[1]}), d = gelu_pk((f32x2){v1[2], v1[3]});
                        v0 = (f32x4){a.x, a.y, b.x, b.y}; v1 = (f32x4){c.x, c.y, d.x, d.y}; }
                    v0 = v0 * sc; v1 = v1 * sc; u32x4 w; w.x = cvt_pk_bf16(v0[0], v0[1]); w.y = cvt_pk_bf16(v0[2], v0[3]); w.z = cvt_pk_bf16(v1[0], v1[1]); w.w = cvt_pk_bf16(v1[2], v1[3]);
                    *(u32x4*)(rowp + bj * HALF) = w; } }
    }
};
template <class Epi, class Sched, bool ALIGN_EPI = false, bool SP2 = false>
__device__ __forceinline__ void gemm_phase(PG8_LAS unsigned char* lds, const Gemm g, const Sched& S, const Epi& E) {
    const int tid = tid_fresh(), wid = __builtin_amdgcn_readfirstlane(tid >> 6), lane = tid & 63, wr = wid >> 2, wc = wid & 3, fr = lane & 15, fq = lane >> 4;
    const int K = g.K, nt = K / BK;
    unsigned voffA[2], voffB[2];
#pragma unroll
    for (int i = 0; i < 2; ++i) { int R, C; stage_rc(tid * 16 + i * 8192, R, C); const int Rb = Epi::PERM ? ((R & ~31) + perm32(R & 31)) : R;
        voffA[i] = (unsigned)(R * K + C) * 2u; voffB[i] = (unsigned)(Rb * K + C) * 2u; }
    const size_t kstep = (size_t)(BK * 2);
    const size_t hstep = (size_t)HALF * K * 2;
    const size_t tstep = 2 * hstep;
    const unsigned ldsw = (unsigned)wid * 1024u;
    const int aoff = lds_byte(wr * 64 + fr, fq * 8), boff = lds_byte(wc * 32 + fr, fq * 8);
#define PG8_SA(b, h) (((b) * 2 + (h)) * HTB)
#define PG8_SB(b, h) ((4 + (b) * 2 + (h)) * HTB)
#define PG8_STAGE(bufoff, gbase, voff) do { _Pragma("unroll") for (int _i = 0; _i < 2; ++_i) \
        __builtin_amdgcn_global_load_lds((const unsigned*)((const char*)(gbase) + (voff)[_i]), (PG8_LAS unsigned*)(lds + (bufoff) + ldsw + _i * 8192), 16, 0, 0); } while (0)
#define PG8_LDA(dst, b, h) do { _Pragma("unroll") for (int m = 0; m < 4; ++m) _Pragma("unroll") for (int k = 0; k < 2; ++k) dst[m][k] = *(const PG8_LAS bf16x8*)(lds + PG8_SA(b, h) + aoff + m * 2048 + k * 1024); } while (0)
#define PG8_LDB(dst, b, h) do { _Pragma("unroll") for (int n = 0; n < 2; ++n) _Pragma("unroll") for (int k = 0; k < 2; ++k) dst[n][k] = *(const PG8_LAS bf16x8*)(lds + PG8_SB(b, h) + boff + n * 2048 + k * 1024); } while (0)
#define PG8_MMA(ai, bj, At, Bt) do { __builtin_amdgcn_s_setprio(1); _Pragma("unroll") for (int m = 0; m < 4; ++m) _Pragma("unroll") for (int n = 0; n < 2; ++n) _Pragma("unroll") for (int k = 0; k < 2; ++k) \
        acc[ai][bj][m][n] = __builtin_amdgcn_mfma_f32_16x16x32_bf16(Bt[n][k], At[m][k], acc[ai][bj][m][n], 0, 0, 0); __builtin_amdgcn_s_setprio(0); } while (0)
#define PG8_WAIT_V(n) asm volatile("s_waitcnt vmcnt(" #n ")" ::: "memory")
#define PG8_WAIT_L(n) asm volatile("s_waitcnt lgkmcnt(" #n ")" ::: "memory")
#define PG8_BAR __builtin_amdgcn_s_barrier()
#define PG8_SCHED __builtin_amdgcn_sched_barrier(0)
    Unit cur, nxt; int ui = 0;
    if (!S.next(0, cur)) return;
    f32x4 acc[2][2][4][2];
#pragma unroll
    for (int a = 0; a < 2; ++a)
#pragma unroll
        for (int b = 0; b < 2; ++b)
#pragma unroll
            for (int m = 0; m < 4; ++m)
#pragma unroll
                for (int n = 0; n < 2; ++n) acc[a][b][m][n] = (f32x4){0.f, 0.f, 0.f, 0.f};
    bf16x8 At[4][2], B0[2][2], B1[2][2];
    const char* cA = (const char*)g.A + (size_t)cur.pm * tstep; const char* cB = (const char*)g.Bt + (size_t)cur.pn * tstep;
    S.a_ready(cur);
    if constexpr (SP2) {
        PG8_STAGE(PG8_SB(0, 0), cB, voffB); PG8_STAGE(PG8_SB(0, 1), cB + hstep, voffB); PG8_STAGE(PG8_SA(0, 0), cA, voffA); PG8_STAGE(PG8_SA(0, 1), cA + hstep, voffA);
        if (wr == 1) PG8_BAR;
        PG8_WAIT_V(2); PG8_BAR;
        PG8_STAGE(PG8_SB(1, 0), cB + kstep, voffB); PG8_STAGE(PG8_SA(1, 0), cA + kstep, voffA); PG8_STAGE(PG8_SB(1, 1), cB + hstep + kstep, voffB);
        PG8_WAIT_V(6); PG8_BAR;
    } else {
        PG8_STAGE(PG8_SB(0, 0), cB, voffB); PG8_STAGE(PG8_SA(0, 0), cA, voffA); PG8_STAGE(PG8_SB(0, 1), cB + hstep, voffB); PG8_STAGE(PG8_SA(0, 1), cA + hstep, voffA);
        if (wr == 1) PG8_BAR;
        PG8_WAIT_V(4); PG8_BAR;
        PG8_STAGE(PG8_SB(1, 0), cB + kstep, voffB); PG8_STAGE(PG8_SA(1, 0), cA + kstep, voffA); PG8_STAGE(PG8_SB(1, 1), cB + hstep + kstep, voffB);
        PG8_WAIT_V(6); PG8_BAR;
    }
    for (;;) {
        const bool has_next = S.next(ui + 1, nxt);
        const char* nA = has_next ? (const char*)g.A + (size_t)nxt.pm * tstep : cA; const char* nB = has_next ? (const char*)g.Bt + (size_t)nxt.pn * tstep : cB;
        for (int t = 0; t < nt; t += 2) {
            const bool last = (t == nt - 2);
            const char* a1 = cA + (size_t)(t + 1) * kstep;
            const char* a2 = last ? nA : cA + (size_t)(t + 2) * kstep; const char* b2 = last ? nB : cB + (size_t)(t + 2) * kstep;
            const char* a3 = a2 + kstep; const char* b3 = b2 + kstep;
            if (last && has_next) S.a_ready(nxt);
            if constexpr (SP2) {
            PG8_LDB(B0, 0, 0); PG8_LDB(B1, 0, 1); PG8_SCHED; PG8_LDA(At, 0, 0); PG8_STAGE(PG8_SA(1, 1), a1 + hstep, voffA);
            PG8_WAIT_V(8); PG8_WAIT_L(0); PG8_BAR; PG8_MMA(0, 0, At, B0); PG8_MMA(0, 1, At, B1); PG8_BAR; PG8_SCHED;
            PG8_LDA(At, 0, 1); PG8_STAGE(PG8_SB(0, 0), b2, voffB); PG8_STAGE(PG8_SB(0, 1), b2 + hstep, voffB); PG8_STAGE(PG8_SA(0, 0), a2, voffA);
            PG8_WAIT_V(8); PG8_WAIT_L(0); PG8_BAR; PG8_MMA(1, 0, At, B0); PG8_MMA(1, 1, At, B1); PG8_BAR; PG8_SCHED;
            PG8_LDB(B0, 1, 0); PG8_LDB(B1, 1, 1); PG8_SCHED; PG8_LDA(At, 1, 0); PG8_STAGE(PG8_SA(0, 1), a2 + hstep, voffA);
            PG8_WAIT_V(8); PG8_WAIT_L(0); PG8_BAR; PG8_MMA(0, 0, At, B0); PG8_MMA(0, 1, At, B1); PG8_BAR; PG8_SCHED;
            PG8_LDA(At, 1, 1); PG8_STAGE(PG8_SB(1, 0), b3, voffB); PG8_STAGE(PG8_SB(1, 1), b3 + hstep, voffB); PG8_STAGE(PG8_SA(1, 0), a3, voffA);
            PG8_WAIT_V(8); PG8_WAIT_L(0); PG8_BAR; PG8_MMA(1, 0, At, B0); PG8_MMA(1, 1, At, B1); PG8_BAR; PG8_SCHED;
            } else {
            PG8_LDB(B0, 0, 0); PG8_SCHED; PG8_LDA(At, 0, 0); PG8_STAGE(PG8_SA(1, 1), a1 + hstep, voffA);
            PG8_WAIT_L(8); PG8_BAR; PG8_WAIT_L(0); PG8_MMA(0, 0, At, B0); PG8_BAR; PG8_SCHED;
            PG8_LDB(B1, 0, 1); PG8_STAGE(PG8_SB(0, 0), b2, voffB);
            PG8_BAR; PG8_WAIT_L(0); PG8_MMA(0, 1, At, B1); PG8_BAR;
            PG8_LDA(At, 0, 1); PG8_STAGE(PG8_SA(0, 0), a2, voffA);
            PG8_BAR; PG8_WAIT_L(0); PG8_MMA(1, 0, At, B0); PG8_BAR; PG8_SCHED;
            PG8_STAGE(PG8_SB(0, 1), b2 + hstep, voffB);
            PG8_WAIT_V(6); PG8_BAR; PG8_MMA(1, 1, At, B1); PG8_BAR;
            PG8_LDB(B0, 1, 0); PG8_SCHED; PG8_LDA(At, 1, 0); PG8_STAGE(PG8_SA(0, 1), a2 + hstep, voffA);
            PG8_WAIT_L(8); PG8_BAR; PG8_WAIT_L(0); PG8_MMA(0, 0, At, B0); PG8_BAR; PG8_SCHED;
            PG8_LDB(B1, 1, 1); PG8_STAGE(PG8_SB(1, 0), b3, voffB);
            PG8_BAR; PG8_WAIT_L(0); PG8_MMA(0, 1, At, B1); PG8_BAR;
            PG8_LDA(At, 1, 1); PG8_STAGE(PG8_SA(1, 0), a3, voffA);
            PG8_BAR; PG8_WAIT_L(0); PG8_MMA(1, 0, At, B0); PG8_BAR; PG8_SCHED;
            PG8_STAGE(PG8_SB(1, 1), b3 + hstep, voffB);
            PG8_WAIT_V(6); PG8_BAR; PG8_MMA(1, 1, At, B1); PG8_BAR;
            }
        }
        if constexpr (ALIGN_EPI) { if (wr == 0) PG8_BAR; }
        if constexpr (!Epi::AFTER_DRAIN) { E(acc, cur, wr, wc, fr, fq); S.done(cur); }
        if (!has_next) break;
#pragma unroll
        for (int a = 0; a < 2; ++a)
#pragma unroll
            for (int b = 0; b < 2; ++b)
#pragma unroll
                for (int m = 0; m < 4; ++m)
#pragma unroll
                    for (int n = 0; n < 2; ++n) acc[a][b][m][n] = (f32x4){0.f, 0.f, 0.f, 0.f};
        cur = nxt; cA = nA; cB = nB; ++ui;
        if constexpr (ALIGN_EPI) { if (wr == 1) PG8_BAR; }
    }
    PG8_WAIT_V(0);
    if constexpr (!ALIGN_EPI) { if (wr == 0) PG8_BAR; }
    PG8_BAR;
    if constexpr (Epi::AFTER_DRAIN) { E.fused(acc, cur, wr, wc, fr, fq, lds, wid, lane); S.done(cur); }
#undef PG8_SA
#undef PG8_SB
#undef PG8_STAGE
#undef PG8_LDA
#undef PG8_LDB
#undef PG8_MMA
#undef PG8_WAIT_V
#undef PG8_WAIT_L
#undef PG8_BAR
#undef PG8_SCHED
}
}

namespace pg8 {
struct EpiSwiglu {
    static constexpr bool PERM = true, AFTER_DRAIN = false;
    bf16_t* O; int ldc;
    __device__ __forceinline__ void operator()(const f32x4 (&acc)[2][2][4][2], const Unit& u, int wr, int wc, int fr, int fq) const {
        const int row0 = u.pm * BM + wr * 64 + fr; const int col0 = u.pn * HALF + wc * 32 + 8 * fq;
#pragma unroll
        for (int ai = 0; ai < 2; ++ai)
#pragma unroll
            for (int m = 0; m < 4; ++m) { bf16_t* rowp = O + (size_t)(row0 + ai * HALF + m * 16) * ldc + col0;
                float hv[8];
#pragma unroll
                for (int n = 0; n < 2; ++n)
#pragma unroll
                    for (int i = 0; i < 4; ++i) { const float g = acc[ai][0][m][n][i], up = acc[ai][1][m][n][i];
                        hv[n * 4 + i] = g * __builtin_amdgcn_rcpf(1.0f + __expf(-g)) * up; }
                u32x4 w; w.x = cvt_pk_bf16(hv[0], hv[1]); w.y = cvt_pk_bf16(hv[2], hv[3]); w.z = cvt_pk_bf16(hv[4], hv[5]); w.w = cvt_pk_bf16(hv[6], hv[7]);
                *(u32x4*)rowp = w; }
    }
};
}

#define LAS __attribute__((address_space(3)))
typedef unsigned short bf16;
typedef float f32x4 __attribute__((ext_vector_type(4)));
typedef short bf16x8 __attribute__((ext_vector_type(8)));
typedef short bf16x4 __attribute__((ext_vector_type(4)));
typedef unsigned v4u __attribute__((ext_vector_type(4)));
typedef unsigned v2u __attribute__((ext_vector_type(2)));

#define XB_TMO      128
#define XB_XCNT(j)  (256  + 64 * (j))
#define XB_XSUB(j)  (1280 + 64 * (j))
#define XB_XGEN(j)  (2304 + 64 * (j))
#define XB_TOP      3328
#define XB_TOPGEN   3392
#define XCD_BAR_WORDS 3456
#define XB_SPIN_CAP (1u << 18)

__device__ __forceinline__ unsigned xb_ld(unsigned* p)              { return __hip_atomic_load(p, __ATOMIC_RELAXED, __HIP_MEMORY_SCOPE_AGENT); }
__device__ __forceinline__ unsigned xb_add(unsigned* p, unsigned v) { return __hip_atomic_fetch_add(p, v, __ATOMIC_RELAXED, __HIP_MEMORY_SCOPE_AGENT); }
__device__ __forceinline__ unsigned xb_xcc_id() { return (unsigned)__builtin_amdgcn_s_getreg((3 << 11) | 20) & 0xFu; }
#define XB_SPIN(cond, bar) do { unsigned _sp = 0; while (cond) { __builtin_amdgcn_s_sleep(1); \
    if ((++_sp & 255u) == 0u) { if (xb_ld(&(bar)[XB_TMO])) break; if (_sp > XB_SPIN_CAP) { atomicAdd(&(bar)[XB_TMO], 1u); break; } } } } while (0)

struct XcdBarrier {
    unsigned* bar; unsigned x;
    volatile LAS unsigned* st;
};

__device__ __forceinline__ XcdBarrier xcd_barrier_post(unsigned* bar, volatile LAS unsigned* st) {
    XcdBarrier b; b.bar = bar; b.x = xb_xcc_id(); b.st = st;
    if (threadIdx.x == 0) (void)xb_add(&bar[XB_XCNT(b.x)], 1u);
    return b;
}
__device__ __forceinline__ void xcd_barrier_complete(unsigned* bar, unsigned x, unsigned& nloc, unsigned& nx) {
    const unsigned G = gridDim.x * gridDim.y * gridDim.z;
    unsigned sum, cnt, mine, sp = 0u;
    for (;;) {
        sum = 0u; cnt = 0u; mine = 0u;
#pragma unroll
        for (unsigned j = 0; j < 16; ++j) { const unsigned c = xb_ld(&bar[XB_XCNT(j)]); sum += c; cnt += (c > 0u) ? 1u : 0u; mine = (j == x) ? c : mine; }
        if (sum == G) break;
        __builtin_amdgcn_s_sleep(1);
        if ((++sp & 255u) == 0u) { if (xb_ld(&bar[XB_TMO])) break; if (sp > XB_SPIN_CAP) { atomicAdd(&bar[XB_TMO], 1u); break; } }
    }
    nloc = mine > 0u ? mine : 1u; nx = cnt > 0u ? cnt : 1u;
}

__device__ __forceinline__ void xcd_barrier(const XcdBarrier& b) {
    asm volatile("s_waitcnt vmcnt(0)" ::: "memory");
    __syncthreads();
    if (threadIdx.x == 0) {
        unsigned* bar = b.bar;
        __builtin_amdgcn_s_waitcnt(0);
        unsigned nloc = b.st[0], nx = b.st[1];
        if (nloc == 0u) { xcd_barrier_complete(bar, b.x, nloc, nx); b.st[0] = nloc; b.st[1] = nx; }
        const unsigned old = xb_add(&bar[XB_XSUB(b.x)], 1u);
        const unsigned gen = old / nloc;
        if (old + 1u == (gen + 1u) * nloc) {
            __builtin_amdgcn_fence(__ATOMIC_RELEASE, "agent");
            asm volatile("s_waitcnt vmcnt(0)" ::: "memory");
            const unsigned og = xb_add(&bar[XB_TOP], 1u);
            const unsigned tg = og / nx;
            if (og + 1u == (tg + 1u) * nx) xb_add(&bar[XB_TOPGEN], 1u);
            else XB_SPIN(xb_ld(&bar[XB_TOPGEN]) == tg, bar);
            __builtin_amdgcn_fence(__ATOMIC_ACQUIRE, "agent");
            xb_add(&bar[XB_XGEN(b.x)], 1u);
            asm volatile("s_waitcnt vmcnt(0)" ::: "memory");
        } else {
            XB_SPIN(xb_ld(&bar[XB_XGEN(b.x)]) == gen, bar);
            __builtin_amdgcn_fence(__ATOMIC_ACQUIRE, "agent");
            asm volatile("s_waitcnt vmcnt(0)" ::: "memory");
        }
    }
    __syncthreads();
}

constexpr int NROWS = 16896, NP = 16384, DM = 1024, DFF = 2816, ZW = 2816;
constexpr float EPS = 1e-6f;
constexpr size_t MiB = 1u << 20;
constexpr size_t WS_WGU1 = 0, WS_WD1 = 11 * MiB, WS_WIN = 17 * MiB, WS_WOUT = 23 * MiB, WS_WGU2 = 25 * MiB, WS_WD2 = 36 * MiB;
constexpr size_t WS_XN = 42 * MiB, WS_HZ = 75 * MiB, WS_Y = 166 * MiB, WS_CT = 199 * MiB, WS_NB = 231 * MiB, WS_GATES = 232 * MiB, WS_MST = 233 * MiB, WS_DEC = WS_MST + 65536, WS_CTL = 234 * MiB, WS_RS = 236 * MiB  ;
constexpr size_t O_YS = 16777216, O_PSK = 17301504, O_PSV = 17334272, O_PC = 17367040, O_PN = 17498112, O_PM = 17499136,
                 O_SSK = 17499144, O_SSV = 19596296, O_SC = 21693448, O_SN = 30082056, O_SM = 30147592;
constexpr int LDS_BYTES = 131072 + 1024;

struct Params { const float* in[16]; float* out; unsigned char* ws; };

__device__ __forceinline__ unsigned f2bf_sw(float f) { unsigned u = __builtin_bit_cast(unsigned, f); return (u + 0x7fffu + ((u >> 16) & 1u)) >> 16; }
__device__ __forceinline__ unsigned pk2_sw(float lo, float hi) { return f2bf_sw(lo) | (f2bf_sw(hi) << 16); }
__device__ __forceinline__ unsigned pk2(float lo, float hi) { unsigned r; asm("s_nop 0\n\tv_cvt_pk_bf16_f32 %0, %1, %2\n\ts_nop 1" : "=v"(r) : "v"(lo), "v"(hi)); return r; }
__device__ __forceinline__ unsigned f2bf(float f) { return pk2(f, 0.f) & 0xffffu; }
__device__ __forceinline__ float bf2f(unsigned b) { return __builtin_bit_cast(float, b << 16); }
__device__ __forceinline__ float bflo(unsigned w) { return __builtin_bit_cast(float, w << 16); }
__device__ __forceinline__ float bfhi(unsigned w) { return __builtin_bit_cast(float, w & 0xffff0000u); }
#define DPP_F(v, ctrl) __builtin_bit_cast(float, __builtin_amdgcn_update_dpp(0, __builtin_bit_cast(int, (v)), (ctrl), 0xF, 0xF, true))
#define RDL_F(v, l) __builtin_bit_cast(float, __builtin_amdgcn_readlane(__builtin_bit_cast(int, (v)), (l)))
__device__ __forceinline__ float wave_sum(float v) {
    v += DPP_F(v, 0xB1); v += DPP_F(v, 0x4E); v += DPP_F(v, 0x141); v += DPP_F(v, 0x140);
    return (RDL_F(v, 0) + RDL_F(v, 16)) + (RDL_F(v, 32) + RDL_F(v, 48));
}
__device__ __forceinline__ float wave_max(float v) {
    v = fmaxf(v, DPP_F(v, 0xB1)); v = fmaxf(v, DPP_F(v, 0x4E)); v = fmaxf(v, DPP_F(v, 0x141)); v = fmaxf(v, DPP_F(v, 0x140));
    return fmaxf(fmaxf(RDL_F(v, 0), RDL_F(v, 16)), fmaxf(RDL_F(v, 32), RDL_F(v, 48)));
}
__device__ __forceinline__ float x16_sum(float v) { float a = v, b = v; asm volatile("s_nop 1\n\tv_permlane16_swap_b32 %0, %1\n\ts_nop 0" : "+v"(a), "+v"(b)); return a + b; }
__device__ __forceinline__ float x32_sum(float v) { float a = v, b = v; asm volatile("s_nop 1\n\tv_permlane32_swap_b32 %0, %1\n\ts_nop 0" : "+v"(a), "+v"(b)); return a + b; }
__device__ __forceinline__ float x16_max(float v) { float a = v, b = v; asm volatile("s_nop 1\n\tv_permlane16_swap_b32 %0, %1\n\ts_nop 0" : "+v"(a), "+v"(b)); return fmaxf(a, b); }
__device__ __forceinline__ float x32_max(float v) { float a = v, b = v; asm volatile("s_nop 1\n\tv_permlane32_swap_b32 %0, %1\n\ts_nop 0" : "+v"(a), "+v"(b)); return fmaxf(a, b); }
__device__ __forceinline__ float row16_sum(float v) { v += DPP_F(v, 0xB1); v += DPP_F(v, 0x4E); v += DPP_F(v, 0x141); v += DPP_F(v, 0x140); return v; }
__device__ __forceinline__ float row8_sum(float v) { v += DPP_F(v, 0xB1); v += DPP_F(v, 0x4E); v += DPP_F(v, 0x141); return v; }
#define DPP_FO(idv, v, ctrl, rm) __builtin_bit_cast(float, __builtin_amdgcn_update_dpp(__builtin_bit_cast(int, (float)(idv)), __builtin_bit_cast(int, (v)), (ctrl), (rm), 0xF, false))
__device__ __forceinline__ float scan_sum(float v, int lane) {
    v += DPP_FO(0.f, v, 0x111, 0xF); v += DPP_FO(0.f, v, 0x112, 0xF); v += DPP_FO(0.f, v, 0x114, 0xF); v += DPP_FO(0.f, v, 0x118, 0xF);
    v += DPP_FO(0.f, v, 0x142, 0xA); v += DPP_FO(0.f, v, 0x143, 0xC);
    return v;
}
__device__ __forceinline__ float scan_max(float v, int lane) {
    v = fmaxf(v, DPP_FO(-INFINITY, v, 0x111, 0xF)); v = fmaxf(v, DPP_FO(-INFINITY, v, 0x112, 0xF)); v = fmaxf(v, DPP_FO(-INFINITY, v, 0x114, 0xF)); v = fmaxf(v, DPP_FO(-INFINITY, v, 0x118, 0xF));
    v = fmaxf(v, DPP_FO(-INFINITY, v, 0x142, 0xA)); v = fmaxf(v, DPP_FO(-INFINITY, v, 0x143, 0xC));
    return v;
}
__device__ __forceinline__ float logsig(float x) { return fminf(x, 0.f) - __logf(1.0f + __expf(-fabsf(x))); }
__device__ __forceinline__ bf16x8 cat4(bf16x4 a, bf16x4 b) { bf16x8 r; r[0] = a[0]; r[1] = a[1]; r[2] = a[2]; r[3] = a[3]; r[4] = b[0]; r[5] = b[1]; r[6] = b[2]; r[7] = b[3]; return r; }
__device__ __forceinline__ bf16x8 pack8(f32x4 a, f32x4 b) {
    v4u w; w.x = pk2(a[0], a[1]); w.y = pk2(a[2], a[3]); w.z = pk2(b[0], b[1]); w.w = pk2(b[2], b[3]);
    return __builtin_bit_cast(bf16x8, w);
}
__device__ __forceinline__ bf16x8 tr_frag(const LAS bf16* a0, const LAS bf16* a1) {
    const bf16x4 lo = __builtin_amdgcn_ds_read_tr16_b64_v4i16((LAS bf16x4*)a0), hi = __builtin_amdgcn_ds_read_tr16_b64_v4i16((LAS bf16x4*)a1); return cat4(lo, hi); }
#define MFMA16(a, b, c) __builtin_amdgcn_mfma_f32_16x16x32_bf16((a), (b), (c), 0, 0, 0)
#define VELEM(v, e) (((v)[(e) >> 1] >> (16 * ((e) & 1))) & 0xffffu)

__device__ __forceinline__ void tr_item(const float* W, int ld, int k0, int ncol, bf16* WT, int K, int drow, float scale, const float* gk, LAS float* scr, int lane) {
#pragma unroll
    for (int i = 0; i < 32; ++i) { const int kk = 2 * i + (lane >> 5); scr[kk * 33 + (lane & 31)] = __builtin_nontemporal_load(&W[(size_t)(k0 + kk) * ld + ncol + (lane & 31)]) * scale; }
    asm volatile("s_waitcnt lgkmcnt(0)" ::: "memory");
    const int c = lane & 7;
    f32x4 ga = {1.f, 1.f, 1.f, 1.f}, gb = {1.f, 1.f, 1.f, 1.f}; if (gk) { ga = *(const f32x4*)(gk + k0 + 8 * c); gb = *(const f32x4*)(gk + k0 + 8 * c + 4); }
#pragma unroll
    for (int j = 0; j < 4; ++j) { const int n = (lane >> 3) + 8 * j; const LAS float* s = scr + (8 * c) * 33 + n;
        v4u o; o.x = pk2(s[0 * 33] * ga[0], s[1 * 33] * ga[1]); o.y = pk2(s[2 * 33] * ga[2], s[3 * 33] * ga[3]); o.z = pk2(s[4 * 33] * gb[0], s[5 * 33] * gb[1]); o.w = pk2(s[6 * 33] * gb[2], s[7 * 33] * gb[3]);
        *(v4u*)(WT + (size_t)(drow + n) * K + k0 + 8 * c) = o; }
    asm volatile("s_waitcnt lgkmcnt(0)" ::: "memory");
}

__device__ __forceinline__ void conv_item(const Params& p, LAS float* scr, int lane, int mat, int r) {
    unsigned char* ws = p.ws;
    const float* src; int ld, K, k0, ncol, drow; bf16* dst; float scale = 1.f;
    const float* gk = (mat == 0 || mat == 1) ? p.in[7] : (mat == 3 ? p.in[7] + 2 * DM : ((mat == 4 || mat == 5) ? p.in[7] + 4 * DM : nullptr));
    if (mat == 2 || mat == 6) { const int l = (mat == 6); const int kb = r >> 5, nb = r & 31; src = p.in[10] + (size_t)l * 2816 * 1024; ld = 1024; K = 2816; k0 = kb * 64; ncol = nb * 32; drow = ncol;
        dst = (bf16*)(ws + (l ? WS_WD2 : WS_WD1)); }
    else if (mat == 3) { const int kb = r / 88, nb = r - kb * 88; src = p.in[11]; ld = 2824; K = 1024; k0 = kb * 64; const int zc = nb * 32; ncol = zc + (zc >= 2048 ? 8 : 0); drow = zc; dst = (bf16*)(ws + WS_WIN);
        scale = (zc >= 512 && zc < 1024) ? 0.08838834764831845f : ((zc >= 2048 && zc < 2560) ? 0.125f : 1.f); }
    else if (mat == 7) { const int kb = r >> 5, nb = r & 31; src = p.in[15]; ld = 1024; K = 1024; k0 = kb * 64; ncol = nb * 32; drow = ncol; dst = (bf16*)(ws + WS_WOUT); }
    else { const int l = (mat >= 4), up = (mat & 1); const int kb = r / 88, nb = r - kb * 88; src = (up ? p.in[9] : p.in[8]) + (size_t)l * 1024 * 2816; ld = 2816; K = 1024; k0 = kb * 64; ncol = nb * 32;
        drow = 256 * (ncol >> 7) + (ncol & 127) + 128 * up; dst = (bf16*)(ws + (l ? WS_WGU2 : WS_WGU1)); }
    tr_item(src, ld, k0, ncol, dst, K, drow, scale, gk, scr, lane);
}
__device__ __forceinline__ void conv_tail_a(const Params& p, LAS unsigned char* L, int gwi, int ngwi) {
    const int tid = tid_fresh(), lane = tid & 63, wave = tid >> 6; LAS float* scr = (LAS float*)(L + wave * 16384);
    for (int it = gwi * 8 + wave; it < 3328; it += ngwi * 8) { if (it < 1408) conv_item(p, scr, lane, 3, it); else if (it < 2816) conv_item(p, scr, lane, 6, it - 1408); else conv_item(p, scr, lane, 7, it - 2816); }
    __syncthreads();
}

__device__ __forceinline__ void prologue(const Params& p, LAS unsigned char* L) {
    const int tid = tid_fresh(), lane = tid & 63, wave = tid >> 6;
    LAS float* scr = (LAS float*)(L + wave * 16384);
    const int gw = blockIdx.x * 8 + wave, NGW = gridDim.x * 8;
    unsigned char* ws = p.ws;
    for (int it = gw; it < 4224; it += NGW) { const int mat = it / 1408; conv_item(p, scr, lane, mat, it - mat * 1408); }
    const f32x4* g0 = (const f32x4*)(p.in[7]);
    f32x4 gv[4];
#pragma unroll
    for (int j = 0; j < 4; ++j) gv[j] = g0[64 * j + lane];
    bf16* XN = (bf16*)(ws + WS_XN);
    f32x4 v[4], vn[4];
#define PX_LOAD(R, V) do { const int r_ = (R); const float* xin = r_ < NP ? p.in[0] + (size_t)r_ * DM : p.in[1] + (size_t)(r_ - NP) * DM; _Pragma("unroll") for (int j = 0; j < 4; ++j) V[j] = __builtin_nontemporal_load(&((const f32x4*)xin)[64 * j + lane]); } while (0)
    PX_LOAD(gw < NROWS ? gw : 0, v);
    for (int r = gw; r < NROWS; r += NGW) {
        PX_LOAD((r + NGW) < NROWS ? (r + NGW) : r, vn);
        float ss = 0.f;
#pragma unroll
        for (int j = 0; j < 4; ++j) ss += (v[j][0] * v[j][0] + v[j][1] * v[j][1]) + (v[j][2] * v[j][2] + v[j][3] * v[j][3]);
        const float m0 = wave_sum(ss) * (1.f / DM) + EPS; const float rs = rsqrtf(m0);
        if (lane == 0) ((float*)(ws + WS_RS))[2 * NROWS + r] = sqrtf(m0);
        v2u* o = (v2u*)(XN + (size_t)r * DM);
#pragma unroll
        for (int j = 0; j < 4; ++j) { v2u w; w.x = pk2(v[j][0] * rs, v[j][1] * rs); w.y = pk2(v[j][2] * rs, v[j][3] * rs); o[64 * j + lane] = w; }
#pragma unroll
        for (int j = 0; j < 4; ++j) v[j] = vn[j];
    }
#undef PX_LOAD
}

template <bool FIRST, bool LAST, bool GATES>
__device__ __forceinline__ void row_pass(const Params& p, LAS unsigned char* L, float coef, int gpost, int gpre, const bf16* xb_in, bf16* xb_out, const float* ir_in, float* ir_out) {
    const int tid = tid_fresh(), lane = tid & 63, wave = tid >> 6;
    const int gw = blockIdx.x * 8 + wave, NGW = gridDim.x * 8;
    unsigned char* ws = p.ws;
    LAS f32x4* GWa = (LAS f32x4*)L; LAS f32x4* GWb = (LAS f32x4*)(L + 16384);
    if (GATES) {
        const float* win = p.in[11];
        for (int idx = tid; idx < 8192; idx += 512) { const int k = idx >> 3, g = idx & 7; const float val = win[(size_t)k * 2824 + 2048 + g];
            const int j = k >> 8, ln = (k & 255) >> 2, i = k & 3; const int kk = (j * 4 + i) * 64 + ln;
            ((LAS float*)L)[(g < 4 ? 0 : 4096) + kk * 4 + (g & 3)] = val; }
        __syncthreads();
    }
    f32x4 gp[4], gq[4];
#pragma unroll
    for (int j = 0; j < 4; ++j) { gp[j] = ((const f32x4*)(p.in[7] + gpost * DM))[64 * j + lane] * coef; gq[j] = LAST ? gp[j] : ((const f32x4*)(p.in[7] + gpre * DM))[64 * j + lane]; }
    const bf16* Y = (const bf16*)(ws + WS_Y); float* GA = (float*)(ws + WS_GATES);
    f32x4 xf[4], xfn[4]; v2u xh[4], xhn[4]; v2u yr[4], ynx[4];
#define RP_LOAD(R, XF, XH, YR) do { const int r_ = (R); \
        if (FIRST) { const float* xin = r_ < NP ? p.in[0] + (size_t)r_ * DM : p.in[1] + (size_t)(r_ - NP) * DM; _Pragma("unroll") for (int j = 0; j < 4; ++j) XF[j] = ((const f32x4*)xin)[64 * j + lane]; } \
        else { _Pragma("unroll") for (int j = 0; j < 4; ++j) XH[j] = ((const v2u*)(xb_in + (size_t)r_ * DM))[64 * j + lane]; } \
        _Pragma("unroll") for (int j = 0; j < 4; ++j) YR[j] = ((const v2u*)(Y + (size_t)r_ * DM))[64 * j + lane]; } while (0)
    RP_LOAD(gw < NROWS ? gw : 0, xf, xh, yr);
    float irc = FIRST ? 1.f : ir_in[gw < NROWS ? gw : 0];
    for (int r = gw; r < NROWS; r += NGW) {
        RP_LOAD((r + NGW) < NROWS ? (r + NGW) : r, xfn, xhn, ynx);
        const float irn = FIRST ? 1.f : ir_in[(r + NGW) < NROWS ? (r + NGW) : r];
        f32x4 xv[4], yv[4]; float ss = 0.f;
#pragma unroll
        for (int j = 0; j < 4; ++j) { const v2u yy = yr[j];
            xv[j] = FIRST ? xf[j] : (f32x4){bflo(xh[j].x), bfhi(xh[j].x), bflo(xh[j].y), bfhi(xh[j].y)} * irc;
            yv[j] = (f32x4){bflo(yy.x), bfhi(yy.x), bflo(yy.y), bfhi(yy.y)}; ss += (yv[j][0] * yv[j][0] + yv[j][1] * yv[j][1]) + (yv[j][2] * yv[j][2] + yv[j][3] * yv[j][3]); }
        const float r1 = rsqrtf(wave_sum(ss) * (1.f / DM) + EPS);
        float s2 = 0.f;
#pragma unroll
        for (int j = 0; j < 4; ++j) { xv[j] = xv[j] + yv[j] * r1 * gp[j];
            if (LAST) __builtin_nontemporal_store(xv[j], &((f32x4*)(p.out + (size_t)r * DM))[64 * j + lane]);
            s2 += (xv[j][0] * xv[j][0] + xv[j][1] * xv[j][1]) + (xv[j][2] * xv[j][2] + xv[j][3] * xv[j][3]); }
        if (!LAST) {
            const float m2 = wave_sum(s2) * (1.f / DM) + EPS; const float r2 = rsqrtf(m2);
            v2u* o = (v2u*)(xb_out + (size_t)r * DM);
#pragma unroll
            for (int j = 0; j < 4; ++j) { xv[j] = xv[j] * r2; v2u w; w.x = pk2(xv[j][0], xv[j][1]); w.y = pk2(xv[j][2], xv[j][3]); o[64 * j + lane] = w; }
            if (lane == 0) ir_out[r] = sqrtf(m2);
            if (GATES) {
#pragma unroll
                for (int j = 0; j < 4; ++j) xv[j] = xv[j] * gq[j];
                f32x4 ga = {0.f, 0.f, 0.f, 0.f}, gb = {0.f, 0.f, 0.f, 0.f};
#pragma unroll
                for (int j = 0; j < 4; ++j)
#pragma unroll
                    for (int i = 0; i < 4; ++i) { const int kk = (j * 4 + i) * 64 + lane; ga += GWa[kk] * xv[j][i]; gb += GWb[kk] * xv[j][i]; }
#pragma unroll
                for (int i = 0; i < 4; ++i) { ga[i] = wave_sum(ga[i]); gb[i] = wave_sum(gb[i]); }
                if (lane == 0) { const f32x4 b0 = ((const f32x4*)p.in[12])[0], b1 = ((const f32x4*)p.in[12])[1]; ((f32x4*)(GA + (size_t)r * 8))[0] = ga + b0; ((f32x4*)(GA + (size_t)r * 8))[1] = gb + b1; }
            }
        }
#pragma unroll
        for (int j = 0; j < 4; ++j) { if (FIRST) xf[j] = xfn[j]; else xh[j] = xhn[j]; yr[j] = ynx[j]; }
        irc = irn;
    }
#undef RP_LOAD
    if (GATES) __syncthreads();
}

__device__ __forceinline__ void stats_item(const Params& p, LAS unsigned char* L, int bh) {
    const int tid = tid_fresh(), lane = tid & 63, wave = tid >> 6; const int b = bh >> 2, h = bh & 3;
    LAS float* sBL = (LAS float*)L; LAS float* sGM = (LAS float*)(L + 512);
    const float* GA = (const float*)(p.ws + WS_GATES);
    float igv[16], fgv[16];
#pragma unroll
    for (int ci = 0; ci < 16; ++ci) { const int ch = wave + 8 * ci; const size_t row = (size_t)b * 8192 + ch * 64 + lane; igv[ci] = GA[row * 8 + h]; fgv[ci] = GA[row * 8 + 4 + h]; }
#pragma unroll
    for (int ci = 0; ci < 16; ++ci) { const int ch = wave + 8 * ci;
        const float bc = scan_sum(logsig(fgv[ci]), lane); const float bL = RDL_F(bc, 63); const float gm = wave_max(bL - bc + igv[ci]);
        if (lane == 0) { sBL[ch] = bL; sGM[ch] = gm; } }
    __syncthreads();
    if (wave == 0) {
        const float a0 = sBL[2 * lane], b0 = sGM[2 * lane], a1 = sBL[2 * lane + 1], b1 = sGM[2 * lane + 1];
        float A = a0 + a1, B = fmaxf(b0 + a1, b1);
#pragma unroll
        for (int o = 1; o < 64; o <<= 1) { const float Ap = __shfl_up(A, o), Bp = __shfl_up(B, o); if (lane >= o) { B = fmaxf(Bp + A, B); A = Ap + A; } }
        float Ae = __shfl_up(A, 1), Be = __shfl_up(B, 1); if (lane == 0) { Ae = 0.f; Be = -INFINITY; }
        const float m_in0 = fmaxf(Ae, Be);
        const float m_in1 = fmaxf(m_in0 + a0, b0);
        const float m_out = fmaxf(m_in1 + a1, b1);
        float* MST = (float*)(p.ws + WS_MST) + bh * 132; float* DEC = (float*)(p.ws + WS_DEC) + bh * 128;
        MST[2 * lane] = lane == 0 ? 0.f : m_in0; MST[2 * lane + 1] = m_in1; if (lane == 63) { MST[128] = m_out; p.out[O_PM + bh] = m_out; }
        DEC[2 * lane] = __expf(a0 + (lane == 0 ? 0.f : m_in0) - m_in1); DEC[2 * lane + 1] = __expf(a1 + m_in1 - m_out);
    }
    __syncthreads();
}

__device__ __forceinline__ void mlstm_dcs_phase(const Params& p, LAS unsigned char* L) {
    const int tid = tid_fresh(), lane = tid & 63, wave = tid >> 6, r16 = lane & 15, quad = lane >> 4;
    LAS bf16* sK = (LAS bf16*)L; LAS bf16* sV = (LAS bf16*)(L + 18432); LAS float* sWK = (LAS float*)(L + 36864);
    const int trq = (lane & 15) >> 2, trp = lane & 3;
    const bf16* Z = (const bf16*)(p.ws + WS_HZ); const float* GA = (const float*)(p.ws + WS_GATES); const float* MST = (const float*)(p.ws + WS_MST); const float* DEC = (const float*)(p.ws + WS_DEC);
    v4u kq[2], vq[2]; float ig = 0.f, fg = 0.f, mn = 0.f;
#define DC_LOAD(IT) do { const int bh_ = (IT) >> 7, ch_ = (IT) & 127; const int row0_ = (bh_ >> 2) * 8192 + ch_ * 64, h_ = bh_ & 3; \
        _Pragma("unroll") for (int i = 0; i < 2; ++i) { const int pc = tid + 512 * i, t = pc >> 4, piece = pc & 15; const bf16* zr = Z + (size_t)(row0_ + t) * ZW + h_ * 128 + piece * 8; kq[i] = *(const v4u*)(zr + 512); vq[i] = *(const v4u*)(zr + 1024); } \
        if (wave == 0) { const size_t row = (size_t)row0_ + lane; ig = GA[row * 8 + h_]; fg = GA[row * 8 + 4 + h_]; mn = MST[bh_ * 132 + ch_ + 1]; } } while (0)
    for (int unit = blockIdx.x; unit < 256; unit += gridDim.x) {
        const int bh = unit >> 5, sc = unit & 31;
        f32x4 acc[8]; float nacc = 0.f;
#pragma unroll
        for (int mi = 0; mi < 8; ++mi) acc[mi] = (f32x4){0.f, 0.f, 0.f, 0.f};
        DC_LOAD(bh * 128 + 4 * sc);
        for (int j = 0; j < 4; ++j) {
            const int ch = 4 * sc + j;
            if (wave == 0) { const float bc = scan_sum(logsig(fg), lane); const float bL = RDL_F(bc, 63); sWK[lane] = __expf(bL - bc + ig - mn); }
            __syncthreads();
#pragma unroll
            for (int i = 0; i < 2; ++i) { const int pc = tid + 512 * i, t = pc >> 4, piece = pc & 15; const float wk = sWK[t]; v4u ks;
#pragma unroll
                for (int w = 0; w < 4; ++w) ks[w] = pk2(bflo(kq[i][w]) * wk, bfhi(kq[i][w]) * wk);
                *(LAS v4u*)(sK + t * 144 + piece * 8) = ks; *(LAS v4u*)(sV + t * 144 + piece * 8) = vq[i]; }
            __syncthreads();
            if (j < 3) DC_LOAD(bh * 128 + ch + 1);
            __builtin_amdgcn_sched_barrier(0);
            const float dec = DEC[bh * 128 + ch];
#pragma unroll
            for (int mi = 0; mi < 8; ++mi) acc[mi] = acc[mi] * dec;
#pragma unroll
            for (int kk = 0; kk < 2; ++kk) { const int rb = (32 * kk + 8 * quad + trq) * 144 + 4 * trp; const bf16x8 bfr = tr_frag(sV + rb + 16 * wave, sV + rb + 4 * 144 + 16 * wave);
#pragma unroll
                for (int mi = 0; mi < 8; ++mi) { const bf16x8 afr = tr_frag(sK + rb + 16 * mi, sK + rb + 4 * 144 + 16 * mi); acc[mi] = MFMA16(afr, bfr, acc[mi]); } }
            if (tid < 128) { float s = 0.f;
#pragma unroll 8
                for (int t = 0; t < 64; ++t) s += bf2f(sK[t * 144 + tid]);
                nacc = nacc * dec + s; }
            __syncthreads();
        }
        bf16* ct = (bf16*)(p.ws + WS_CT) + (((size_t)(bh * 128 + 16 * wave + r16) * 32 + sc) << 7);
#pragma unroll
        for (int mi = 0; mi < 8; ++mi) { v2u o; o.x = pk2_sw(acc[mi][0], acc[mi][1]); o.y = pk2_sw(acc[mi][2], acc[mi][3]); *(v2u*)(ct + 16 * mi + 4 * quad) = o; }
        if (tid < 128) ((float*)(p.ws + WS_NB))[(size_t)(bh * 32 + sc) * 128 + tid] = nacc;
    }
#undef DC_LOAD
}

__device__ __forceinline__ void swa_prompt_item(const Params& p, LAS unsigned char* L, int item) {
    const int tid = tid_fresh(), lane = tid & 63, wave = tid >> 6, r16 = lane & 15, quad = lane >> 4;
    const int b = item >> 7, nb = (item >> 1) & 63, kvh = item & 1;
    LAS bf16* sK = (LAS bf16*)L; LAS bf16* sVT = (LAS bf16*)(L + 36864);
    const bf16* Z = (const bf16*)(p.ws + WS_HZ); bf16* U = (bf16*)(p.ws + WS_XN);
#pragma unroll
    for (int i = 0; i < 4; ++i) { const int pc = tid + 512 * i, j = pc >> 3, piece = pc & 7; const int pos = nb * 128 - 128 + j;
        v4u kq = {0u, 0u, 0u, 0u}, vq = {0u, 0u, 0u, 0u};
        if (pos >= 0) { const bf16* zr = Z + (size_t)(b * 8192 + pos) * ZW + kvh * 64 + piece * 8; kq = *(const v4u*)(zr + 2560); vq = *(const v4u*)(zr + 2688); }
        *(LAS v4u*)(sK + j * 72 + piece * 8) = kq; *(LAS v4u*)(sVT + j * 72 + piece * 8) = vq;
        if (nb == 63 && j >= 128) { const size_t o = ((size_t)((b * 128 + (j - 128)) * 2 + kvh)) * 64 + piece * 8; float* ok = p.out + O_PSK + o; float* ov = p.out + O_PSV + o;
            ((f32x4*)ok)[0] = (f32x4){bflo(kq.x), bfhi(kq.x), bflo(kq.y), bfhi(kq.y)}; ((f32x4*)ok)[1] = (f32x4){bflo(kq.z), bfhi(kq.z), bflo(kq.w), bfhi(kq.w)};
            ((f32x4*)ov)[0] = (f32x4){bflo(vq.x), bfhi(vq.x), bflo(vq.y), bfhi(vq.y)}; ((f32x4*)ov)[1] = (f32x4){bflo(vq.z), bfhi(vq.z), bflo(vq.w), bfhi(vq.w)}; } }
    bf16x8 qn0, qn1;
    { const int rt = wave * 4, g = rt >> 3, qt = rt & 7, hh = kvh * 4 + g;
        const size_t qrow = (size_t)b * 8192 + nb * 128 + 16 * qt + r16; const bf16* qp = Z + qrow * ZW + 2048 + hh * 64 + 8 * quad; qn0 = *(const bf16x8*)qp; qn1 = *(const bf16x8*)(qp + 32); }
    __syncthreads();
#pragma nounroll
    for (int i = 0; i < 4; ++i) { const int rt = wave * 4 + i, g = rt >> 3, qt = rt & 7, hh = kvh * 4 + g; const int kt0 = qt < 6 ? qt : 6;
        const bf16x8 qf0 = qn0, qf1 = qn1;
        if (i < 3) { const int rt2 = rt + 1, g2 = rt2 >> 3, qt2 = rt2 & 7, hh2 = kvh * 4 + g2;
            const size_t qrow = (size_t)b * 8192 + nb * 128 + 16 * qt2 + r16; const bf16* qp = Z + qrow * ZW + 2048 + hh2 * 64 + 8 * quad; qn0 = *(const bf16x8*)qp; qn1 = *(const bf16x8*)(qp + 32); }
        f32x4 s[10];
#pragma unroll
        for (int kt = 0; kt < 10; ++kt) { const LAS bf16* kp = sK + (16 * (kt0 + kt) + r16) * 72 + 8 * quad; const bf16x8 k0 = *(const LAS bf16x8*)kp, k1 = *(const LAS bf16x8*)(kp + 32);
            s[kt] = MFMA16(k0, qf0, ((f32x4){0.f, 0.f, 0.f, 0.f})); s[kt] = MFMA16(k1, qf1, s[kt]); }
        const float slope = exp2f(-(float)(hh + 1)), sink = p.in[14][hh]; const int qi = 16 * qt + r16; float mx = sink;
        const float fd0 = (float)(128 + qi - 16 * kt0 - 4 * quad); const unsigned limb = __float_as_uint((float)(nb > 0 ? 128 : (qi + 1 < 128 ? qi + 1 : 128)));
#pragma unroll
        for (int kt = 0; kt < 10; ++kt)
#pragma unroll
            for (int rg = 0; rg < 4; ++rg) { const float fdist = fd0 - (float)(16 * kt + rg); const bool valid = __float_as_uint(fdist) < limb;
                const float v = valid ? s[kt][rg] - slope * fdist : -INFINITY; s[kt][rg] = v; mx = fmaxf(mx, v); }
        mx = x32_max(x16_max(mx));
        float sum = 0.f;
#pragma unroll
        for (int kt = 0; kt < 10; ++kt)
#pragma unroll
            for (int rg = 0; rg < 4; ++rg) { const float e = __expf(s[kt][rg] - mx); s[kt][rg] = e; sum += e; }
        sum = x32_sum(x16_sum(sum));
        const float inv = 1.0f / (sum + __expf(sink - mx));
        f32x4 o[4];
#pragma unroll
        for (int nd = 0; nd < 4; ++nd) o[nd] = (f32x4){0.f, 0.f, 0.f, 0.f};
#pragma unroll
        for (int i2 = 0; i2 < 5; ++i2) { const bf16x8 pa = pack8(s[2 * i2], s[2 * i2 + 1]);
#pragma unroll
            for (int nd = 0; nd < 4; ++nd) { const LAS bf16* vp = sVT + (16 * (kt0 + 2 * i2) + 4 * quad + ((lane & 15) >> 2)) * 72 + 16 * nd + 4 * (lane & 3);
                const bf16x8 vb = tr_frag(vp, vp + 16 * 72); o[nd] = MFMA16(pa, vb, o[nd]); } }
#pragma unroll
        for (int rg = 0; rg < 4; ++rg) { const float iv = __shfl(inv, 4 * quad + rg); const size_t orow = (size_t)b * 8192 + nb * 128 + 16 * qt + 4 * quad + rg;
#pragma unroll
            for (int nd = 0; nd < 4; ++nd) U[orow * DM + 512 + hh * 64 + 16 * nd + r16] = (bf16)f2bf(o[nd][rg] * iv); }
    }
    __syncthreads();
}

__device__ __forceinline__ void swa_sample_item(const Params& p, LAS unsigned char* L, int item) {
    const int tid = tid_fresh(), lane = tid & 63, wave = tid >> 6, r16 = lane & 15, quad = lane >> 4; const int bd = item >> 1, kvh = item & 1; const int row0 = NP + bd * 4;
    LAS bf16* sK = (LAS bf16*)L;
    LAS bf16* sV = (LAS bf16*)(L + 23040);
    const bf16* Z = (const bf16*)(p.ws + WS_HZ); bf16* U = (bf16*)(p.ws + WS_XN);
#pragma unroll
    for (int i = 0; i < 3; ++i) { const int pc = tid + 512 * i; if (pc < 1280) { const int j = pc >> 3, piece = pc & 7; v4u kq = {0u, 0u, 0u, 0u}, vq = {0u, 0u, 0u, 0u};
            if (j < 128) { const size_t o = ((size_t)((bd * 128 + j) * 2 + kvh)) * 64 + piece * 8;
                const f32x4 k0 = __builtin_nontemporal_load((const f32x4*)(p.in[2] + o)), k1 = __builtin_nontemporal_load((const f32x4*)(p.in[2] + o + 4)), v0 = __builtin_nontemporal_load((const f32x4*)(p.in[3] + o)), v1 = __builtin_nontemporal_load((const f32x4*)(p.in[3] + o + 4));
                kq.x = pk2(k0[0], k0[1]); kq.y = pk2(k0[2], k0[3]); kq.z = pk2(k1[0], k1[1]); kq.w = pk2(k1[2], k1[3]);
                vq.x = pk2(v0[0], v0[1]); vq.y = pk2(v0[2], v0[3]); vq.z = pk2(v1[0], v1[1]); vq.w = pk2(v1[2], v1[3]);
                if (j >= 4) { const size_t oo = o - 4 * 128; __builtin_nontemporal_store(k0, (f32x4*)(p.out + O_SSK + oo)); __builtin_nontemporal_store(k1, (f32x4*)(p.out + O_SSK + oo + 4)); __builtin_nontemporal_store(v0, (f32x4*)(p.out + O_SSV + oo)); __builtin_nontemporal_store(v1, (f32x4*)(p.out + O_SSV + oo + 4)); } }
            else if (j < 132) { const bf16* zr = Z + (size_t)(row0 + j - 128) * ZW + kvh * 64 + piece * 8; kq = *(const v4u*)(zr + 2560); vq = *(const v4u*)(zr + 2688);
                const size_t oo = ((size_t)((bd * 128 + (j - 4)) * 2 + kvh)) * 64 + piece * 8;
                *(f32x4*)(p.out + O_SSK + oo) = (f32x4){bflo(kq.x), bfhi(kq.x), bflo(kq.y), bfhi(kq.y)}; *(f32x4*)(p.out + O_SSK + oo + 4) = (f32x4){bflo(kq.z), bfhi(kq.z), bflo(kq.w), bfhi(kq.w)};
                *(f32x4*)(p.out + O_SSV + oo) = (f32x4){bflo(vq.x), bfhi(vq.x), bflo(vq.y), bfhi(vq.y)}; *(f32x4*)(p.out + O_SSV + oo + 4) = (f32x4){bflo(vq.z), bfhi(vq.z), bflo(vq.w), bfhi(vq.w)}; }
            *(LAS v4u*)(sK + j * 72 + piece * 8) = kq; *(LAS v4u*)(sV + j * 72 + piece * 8) = vq; } }
    __syncthreads();
    if (wave == 0) {
        const int sq = r16 >> 2, g = r16 & 3, hh = kvh * 4 + g; const bf16* qp = Z + (size_t)(row0 + sq) * ZW + 2048 + hh * 64 + 8 * quad;
        const bf16x8 qf0 = *(const bf16x8*)qp, qf1 = *(const bf16x8*)(qp + 32);
        f32x4 s[10];
#pragma unroll
        for (int kt = 0; kt < 10; ++kt) { const LAS bf16* kp = sK + (16 * kt + r16) * 72 + 8 * quad; const bf16x8 k0 = *(const LAS bf16x8*)kp, k1 = *(const LAS bf16x8*)(kp + 32);
            s[kt] = MFMA16(k0, qf0, ((f32x4){0.f, 0.f, 0.f, 0.f})); s[kt] = MFMA16(k1, qf1, s[kt]); }
        const float slope = exp2f(-(float)(hh + 1)), sink = p.in[14][hh]; float mx = sink;
#pragma unroll
        for (int kt = 0; kt < 10; ++kt)
#pragma unroll
            for (int rg = 0; rg < 4; ++rg) { const int j = 16 * kt + 4 * quad + rg; const int dist = 128 + sq - j; const bool valid = dist >= 0 && dist < 128;
                const float v = valid ? s[kt][rg] - slope * (float)dist : -INFINITY; s[kt][rg] = v; mx = fmaxf(mx, v); }
        mx = x32_max(x16_max(mx));
        float sum = 0.f;
#pragma unroll
        for (int kt = 0; kt < 10; ++kt)
#pragma unroll
            for (int rg = 0; rg < 4; ++rg) { const float e = __expf(s[kt][rg] - mx); s[kt][rg] = e; sum += e; }
        sum = x32_sum(x16_sum(sum));
        const float inv = 1.0f / (sum + __expf(sink - mx));
        f32x4 o[4];
#pragma unroll
        for (int nd = 0; nd < 4; ++nd) o[nd] = (f32x4){0.f, 0.f, 0.f, 0.f};
#pragma unroll
        for (int i2 = 0; i2 < 5; ++i2) { const bf16x8 pa = pack8(s[2 * i2], s[2 * i2 + 1]);
#pragma unroll
            for (int nd = 0; nd < 4; ++nd) { const LAS bf16* vp = sV + (32 * i2 + 4 * quad + ((lane & 15) >> 2)) * 72 + 16 * nd + 4 * (lane & 3);
                const bf16x8 vb = tr_frag(vp, vp + 16 * 72); o[nd] = MFMA16(pa, vb, o[nd]); } }
#pragma unroll
        for (int rg = 0; rg < 4; ++rg) { const int rq = 4 * quad + rg; const float iv = __shfl(inv, rq); const int so = rq >> 2, go = rq & 3;
#pragma unroll
            for (int nd = 0; nd < 4; ++nd) U[(size_t)(row0 + so) * DM + 512 + (kvh * 4 + go) * 64 + 16 * nd + r16] = (bf16)f2bf(o[nd][rg] * iv); }
    }
    __syncthreads();
}

__device__ __forceinline__ void mlstm_sample_item(const Params& p, LAS unsigned char* L, int item) {
    const int tid = tid_fresh(), lane = tid & 63, wave = tid >> 6; const int bd = item >> 2, h = item & 3; const int row0 = NP + bd * 4;
    LAS float* sq = (LAS float*)L;
    LAS float* sk = sq + 512; LAS float* sv = sq + 1024; LAS float* sn = sq + 1536;
    LAS float* sQK = sq + 1664;
    LAS float* sQN = sq + 1680;
    LAS float* sSS = sq + 1688;
    LAS float* sPart = sq + 1792;
    const bf16* Z = (const bf16*)(p.ws + WS_HZ); bf16* U = (bf16*)(p.ws + WS_XN); const float* GA = (const float*)(p.ws + WS_GATES);
    float cin[32]; { const int v = tid & 127, ks = tid >> 7; const float* Cin = p.in[4] + ((size_t)(bd * 4 + h) << 14);
#pragma unroll
        for (int kk = 0; kk < 32; ++kk) cin[kk] = __builtin_nontemporal_load(&Cin[(ks * 32 + kk) * 128 + v]); }
    const float og_pre = bf2f(Z[(size_t)(row0 + (tid >> 7)) * ZW + 1536 + h * 128 + (tid & 127)]);
    for (int idx = tid; idx < 1536; idx += 512) { const int w = idx >> 9, r = idx & 511, t = r >> 7, d = r & 127; sq[idx] = bf2f(Z[(size_t)(row0 + t) * ZW + w * 512 + h * 128 + d]); }
    if (tid < 128) sn[tid] = p.in[5][(size_t)(bd * 4 + h) * 128 + tid];
    float ig[4], bc[4]; { float a = 0.f;
#pragma unroll
        for (int s = 0; s < 4; ++s) { ig[s] = GA[(size_t)(row0 + s) * 8 + h]; a += logsig(GA[(size_t)(row0 + s) * 8 + 4 + h]); bc[s] = a; } }
    const float m0 = p.in[6][bd * 4 + h];
    float mt[4], at[4], W[4][4];
#pragma unroll
    for (int t = 0; t < 4; ++t) { float md = -INFINITY;
#pragma unroll
        for (int s = 0; s <= t; ++s) md = fmaxf(md, bc[t] - bc[s] + ig[s]);
        mt[t] = fmaxf(bc[t] + m0, md); at[t] = __expf(bc[t] + m0 - mt[t]);
#pragma unroll
        for (int s = 0; s < 4; ++s) W[t][s] = s <= t ? __expf(bc[t] - bc[s] + ig[s] - mt[t]) : 0.f; }
    const float bL = bc[3]; float mnew = bL + m0; float wk[4];
#pragma unroll
    for (int s = 0; s < 4; ++s) mnew = fmaxf(mnew, bL - bc[s] + ig[s]);
    const float decay = __expf(bL + m0 - mnew);
#pragma unroll
    for (int s = 0; s < 4; ++s) wk[s] = __expf(bL - bc[s] + ig[s] - mnew);
    __syncthreads();
#pragma unroll
    for (int i = 0; i < 2; ++i) { const int pr = wave * 2 + i, t = pr >> 2, s = pr & 3; const float a = wave_sum(sq[t * 128 + lane] * sk[s * 128 + lane] + sq[t * 128 + 64 + lane] * sk[s * 128 + 64 + lane]); if (lane == 0) sQK[pr] = a; }
    if (wave < 4) { const float a = wave_sum(sq[wave * 128 + lane] * sn[lane] + sq[wave * 128 + 64 + lane] * sn[64 + lane]); if (lane == 0) sQN[wave] = a; }
    { const int v = tid & 127, ks = tid >> 7; const float* Cin = p.in[4] + ((size_t)(bd * 4 + h) << 14); float* Cout = p.out + O_SC + ((size_t)(bd * 4 + h) << 14);
        const float v0 = sv[v], v1 = sv[128 + v], v2 = sv[256 + v], v3 = sv[384 + v];
        float a0 = 0.f, a1 = 0.f, a2 = 0.f, a3 = 0.f;
#pragma unroll
        for (int kk = 0; kk < 32; ++kk) { const int k = ks * 32 + kk; const float c = cin[kk];
            a0 += sq[k] * c; a1 += sq[128 + k] * c; a2 += sq[256 + k] * c; a3 += sq[384 + k] * c;
            __builtin_nontemporal_store(decay * c + (wk[0] * sk[k] * v0 + wk[1] * sk[128 + k] * v1) + (wk[2] * sk[256 + k] * v2 + wk[3] * sk[384 + k] * v3), &Cout[k * 128 + v]); }
        sPart[(ks * 4 + 0) * 128 + v] = a0; sPart[(ks * 4 + 1) * 128 + v] = a1; sPart[(ks * 4 + 2) * 128 + v] = a2; sPart[(ks * 4 + 3) * 128 + v] = a3; }
    if (tid < 128) p.out[O_SN + (size_t)(bd * 4 + h) * 128 + tid] = decay * sn[tid] + (wk[0] * sk[tid] + wk[1] * sk[128 + tid]) + (wk[2] * sk[256 + tid] + wk[3] * sk[384 + tid]);
    if (tid == 0) p.out[O_SM + bd * 4 + h] = mnew;
    __syncthreads();
    { const int t = tid >> 7, v = tid & 127; const float qc = (sPart[(0 * 4 + t) * 128 + v] + sPart[(1 * 4 + t) * 128 + v]) + (sPart[(2 * 4 + t) * 128 + v] + sPart[(3 * 4 + t) * 128 + v]);
        float att = 0.f, mtt = 0.f, num, den; float S[4];
#pragma unroll
        for (int tt = 0; tt < 4; ++tt) if (tt == t) { att = at[tt]; mtt = mt[tt];
#pragma unroll
            for (int s = 0; s < 4; ++s) S[s] = sQK[tt * 4 + s] * W[tt][s]; }
        num = att * qc + (S[0] * sv[v] + S[1] * sv[128 + v]) + (S[2] * sv[256 + v] + S[3] * sv[384 + v]);
        den = att * sQN[t] + (S[0] + S[1]) + (S[2] + S[3]);
        const float hv = num / fmaxf(fabsf(den), __expf(-mtt));
        const float q2 = wave_sum(hv * hv); if (lane == 0) sSS[wave] = q2;
        __syncthreads();
        const float ss = sSS[2 * t] + sSS[2 * t + 1]; const float rn = rsqrtf(ss * (1.f / 128.f) + EPS);
        const float og = og_pre; const float sg = 1.0f / (1.0f + __expf(-og));
        U[(size_t)(row0 + t) * DM + h * 128 + v] = (bf16)f2bf(hv * rn * p.in[13][h * 128 + v] * sg); }
    __syncthreads();
}

__device__ __forceinline__ void scan_phase(const Params& p, LAS unsigned char* L) {
    const int tid = tid_fresh(), lane = tid & 63, wave = tid >> 6;
    if (tid < 256) {
        for (int gid = blockIdx.x * 256 + tid; gid < 65536; gid += gridDim.x * 256) {
            const int bh = gid >> 13, dv = (gid & 8191) >> 6, dk = (gid & 63) * 2; unsigned* q = (unsigned*)((bf16*)(p.ws + WS_CT) + ((size_t)(bh * 128 + dv) << 12) + dk); const f32x4* dec4 = (const f32x4*)((const float*)(p.ws + WS_DEC) + bh * 128);
            float C0 = 0.f, C1 = 0.f; unsigned d[32]; float dc[32];
#pragma unroll
            for (int u = 0; u < 32; ++u) { d[u] = q[u * 64]; const f32x4 t = dec4[u]; dc[u] = (t[0] * t[1]) * (t[2] * t[3]); }
#pragma unroll
            for (int u = 0; u < 32; ++u) { q[u * 64] = pk2(C0, C1); C0 = dc[u] * C0 + bflo(d[u]); C1 = dc[u] * C1 + bfhi(d[u]); }
            float* pc = p.out + O_PC + ((size_t)bh << 14); pc[dk * 128 + dv] = C0; pc[(dk + 1) * 128 + dv] = C1; }
    } else if (wave == 4) {
        for (int idx = blockIdx.x * 64 + lane; idx < 1024; idx += gridDim.x * 64) { const int bh = idx >> 7, dk = idx & 127; float* q = (float*)(p.ws + WS_NB) + ((size_t)(bh * 32) << 7) + dk; const f32x4* dec4 = (const f32x4*)((const float*)(p.ws + WS_DEC) + bh * 128);
            float n = 0.f; float d[32], dc[32];
#pragma unroll
            for (int u = 0; u < 32; ++u) { d[u] = q[u * 128]; const f32x4 t = dec4[u]; dc[u] = (t[0] * t[1]) * (t[2] * t[3]); }
#pragma unroll
            for (int u = 0; u < 32; ++u) { q[u * 128] = n; n = dc[u] * n + d[u]; }
            p.out[O_PN + idx] = n; }
    }
    { LAS float* scr = (LAS float*)(L + wave * 16384);
        if (wave >= 5) { for (int it = blockIdx.x * 3 + (wave - 5); it < 1536; it += gridDim.x * 3) { if (it < 1408) conv_item(p, scr, lane, 4, it); else conv_item(p, scr, lane, 5, it - 1408); } }
        else { for (int it = 1536 + blockIdx.x * 5 + wave; it < 2816; it += gridDim.x * 5) conv_item(p, scr, lane, 5, it - 1408); } }
}

__device__ __forceinline__ void mlstm_out_phase(const Params& p, LAS unsigned char* L) {
    const int tid = tid_fresh(), lane = tid & 63, wave = tid >> 6, r16 = lane & 15, quad = lane >> 4;
    LAS bf16* sQ = (LAS bf16*)L; LAS bf16* sK = (LAS bf16*)(L + 17408); LAS bf16* sVT = (LAS bf16*)(L + 34816); LAS bf16* sCT = (LAS bf16*)(L + 53248);
    LAS float* sN = (LAS float*)(L + 88064); LAS float* sAl = sN + 128; LAS float* sBe = sAl + 64; LAS float* sA = sBe + 64; LAS float* sEm = sA + 64; LAS float* sQN = sEm + 64; LAS float* sSS = sQN + 64;
    LAS float* sWK = sSS + 128; LAS bf16* sVw = (LAS bf16*)(L + 90624);
    const bf16* Z = (const bf16*)(p.ws + WS_HZ); bf16* U = (bf16*)(p.ws + WS_XN);
    const int trq = (lane & 15) >> 2, trp = lane & 3;
    for (int unit = blockIdx.x; unit < 256; unit += gridDim.x) {
    const int bh = unit >> 5, sc = unit & 31, b = bh >> 2, h = bh & 3;
    { const bf16* ctg = (const bf16*)(p.ws + WS_CT) + ((size_t)(bh * 128) << 12) + ((size_t)sc << 7);
#pragma unroll
        for (int i = 0; i < 4; ++i) { const int pc = tid + 512 * i, dv = pc >> 4, piece = pc & 15; *(LAS v4u*)(sCT + dv * 136 + piece * 8) = *(const v4u*)(ctg + ((size_t)dv << 12) + piece * 8); } }
    if (tid < 128) sN[tid] = ((const float*)(p.ws + WS_NB))[(size_t)(bh * 32 + sc) * 128 + tid];
    __syncthreads();
    f32x4 cst[8];
#pragma unroll
    for (int mi = 0; mi < 8; ++mi) { const v2u w = *(const LAS v2u*)(sCT + (16 * wave + r16) * 136 + 16 * mi + 4 * quad); cst[mi] = (f32x4){bflo(w.x), bfhi(w.x), bflo(w.y), bfhi(w.y)}; }
    v4u nq[2], nk[2], nv[2]; float nig = 0.f, nfg = 0.f;
#define OUT_LOAD(CH) do { const int row0_ = b * 8192 + (CH) * 64; \
        _Pragma("unroll") for (int i = 0; i < 2; ++i) { const int pc = tid + 512 * i, t = pc >> 4, piece = pc & 15; const bf16* zr = Z + (size_t)(row0_ + t) * ZW + h * 128 + piece * 8; nq[i] = *(const v4u*)zr; nk[i] = *(const v4u*)(zr + 512); nv[i] = *(const v4u*)(zr + 1024); } \
        if (wave == 0) { const size_t row = (size_t)row0_ + lane; nig = ((const float*)(p.ws + WS_GATES))[row * 8 + h]; nfg = ((const float*)(p.ws + WS_GATES))[row * 8 + 4 + h]; } } while (0)
    OUT_LOAD(4 * sc);
    for (int j = 0; j < 4; ++j) {
    const int ch = 4 * sc + j; const int row0 = b * 8192 + ch * 64;
    if (wave == 0) { const float ig = nig, fg = nfg; const float bc = scan_sum(logsig(fg), lane); const float be = ig - bc; const float pm = scan_max(be, lane);
        const float mc = ((const float*)(p.ws + WS_MST))[bh * 132 + ch]; const float mt = bc + fmaxf(mc, pm);
        sAl[lane] = bc - mt; sBe[lane] = be; sA[lane] = __expf(bc + mc - mt); sEm[lane] = __expf(-mt);
        const float bL = RDL_F(bc, 63); sWK[lane] = __expf(bL + be - ((const float*)(p.ws + WS_MST))[bh * 132 + ch + 1]); }
#pragma unroll
    for (int i = 0; i < 2; ++i) { const int pc = tid + 512 * i, t = pc >> 4, piece = pc & 15;
        *(LAS v4u*)(sQ + t * 136 + piece * 8) = nq[i]; *(LAS v4u*)(sK + t * 136 + piece * 8) = nk[i];
        *(LAS v4u*)(sVT + t * 144 + piece * 8) = nv[i]; }
    __syncthreads();
    if (j < 3) OUT_LOAD(ch + 1);
    __builtin_amdgcn_sched_barrier(0);
    if (j < 3) {
#pragma unroll
        for (int i = 0; i < 2; ++i) { const int pc = tid + 512 * i, t = pc >> 4, piece = pc & 15; const float wk = sWK[t]; const v4u v4 = *(const LAS v4u*)(sVT + t * 144 + piece * 8); v4u o;
#pragma unroll
            for (int w = 0; w < 4; ++w) o[w] = pk2(bflo(v4[w]) * wk, bfhi(v4[w]) * wk);
            *(LAS v4u*)(sVw + t * 144 + piece * 8) = o; } }
    { const int t = tid >> 3, part = tid & 7; float s = 0.f;
#pragma unroll
        for (int e = 0; e < 16; ++e) s += bf2f(sQ[t * 136 + part * 16 + e]) * sN[part * 16 + e];
        s = row8_sum(s); if (part == 0) sQN[t] = s; }
    __syncthreads();
    const int tt = wave & 3, dh = wave >> 2;
    unsigned short ogr[4][4];
#pragma unroll
    for (int rg = 0; rg < 4; ++rg)
#pragma unroll
        for (int nv = 0; nv < 4; ++nv) ogr[rg][nv] = Z[(size_t)(row0 + 16 * tt + 4 * quad + rg) * ZW + 1536 + h * 128 + 16 * (4 * dh + nv) + r16];
    bf16x8 qf[4];
#pragma unroll
    for (int kk = 0; kk < 4; ++kk) qf[kk] = *(const LAS bf16x8*)(sQ + (16 * tt + r16) * 136 + 8 * quad + 32 * kk);
    f32x4 sT[4];
#pragma unroll
    for (int mi = 0; mi < 4; ++mi) { sT[mi] = (f32x4){0.f, 0.f, 0.f, 0.f};
#pragma unroll
        for (int kk = 0; kk < 4; ++kk) { const bf16x8 kf = *(const LAS bf16x8*)(sK + (16 * mi + r16) * 136 + 8 * quad + 32 * kk); sT[mi] = MFMA16(kf, qf[kk], sT[mi]); } }
    const int tl = 16 * tt + r16; const float al = sAl[tl]; float rs = 0.f;
#pragma unroll
    for (int mi = 0; mi < 4; ++mi)
#pragma unroll
        for (int rg = 0; rg < 4; ++rg) { const int si = 16 * mi + 4 * quad + rg; const float w = si <= tl ? __expf(al + sBe[si]) : 0.f; const float v = sT[mi][rg] * w; sT[mi][rg] = v; rs += v; }
    rs = x32_sum(x16_sum(rs));
    const float den = sA[tl] * sQN[tl] + rs; const float inv = 1.0f / fmaxf(fabsf(den), sEm[tl]);
    bf16x8 pa[2]; pa[0] = pack8(sT[0], sT[1]); pa[1] = pack8(sT[2], sT[3]);
    f32x4 acc[4];
#pragma unroll
    for (int nv = 0; nv < 4; ++nv) { acc[nv] = (f32x4){0.f, 0.f, 0.f, 0.f}; const int dvb = 16 * (4 * dh + nv) + r16;
#pragma unroll
        for (int kk = 0; kk < 4; ++kk) { const bf16x8 cf = *(const LAS bf16x8*)(sCT + dvb * 136 + 8 * quad + 32 * kk); acc[nv] = MFMA16(qf[kk], cf, acc[nv]); } }
#pragma unroll
    for (int rg = 0; rg < 4; ++rg) { const float ar = sA[16 * tt + 4 * quad + rg];
#pragma unroll
        for (int nv = 0; nv < 4; ++nv) acc[nv][rg] *= ar; }
#pragma unroll
    for (int i2 = 0; i2 < 2; ++i2)
#pragma unroll
        for (int nv = 0; nv < 4; ++nv) { const LAS bf16* vp = sVT + (32 * i2 + 4 * quad + ((lane & 15) >> 2)) * 144 + 16 * (4 * dh + nv) + 4 * (lane & 3);
            const bf16x8 vb = tr_frag(vp, vp + 16 * 144); acc[nv] = MFMA16(pa[i2], vb, acc[nv]); }
#pragma unroll
    for (int rg = 0; rg < 4; ++rg) { const float iv = __shfl(inv, 4 * quad + rg); float q2 = 0.f;
#pragma unroll
        for (int nv = 0; nv < 4; ++nv) { acc[nv][rg] *= iv; q2 += acc[nv][rg] * acc[nv][rg]; }
        q2 = row16_sum(q2);
        if (r16 == 0) sSS[dh * 64 + 16 * tt + 4 * quad + rg] = q2; }
    __syncthreads();
    if (j < 3) {
        const float dec = ((const float*)(p.ws + WS_DEC))[bh * 128 + ch];
#pragma unroll
        for (int mi = 0; mi < 8; ++mi) cst[mi] = cst[mi] * dec;
#pragma unroll
        for (int kk = 0; kk < 2; ++kk) { const int rw = 32 * kk + 8 * quad + trq; const bf16x8 bfr = tr_frag(sVw + rw * 144 + 4 * trp + 16 * wave, sVw + (rw + 4) * 144 + 4 * trp + 16 * wave);
#pragma unroll
            for (int mi = 0; mi < 8; ++mi) { const bf16x8 afr = tr_frag(sK + rw * 136 + 4 * trp + 16 * mi, sK + (rw + 4) * 136 + 4 * trp + 16 * mi); cst[mi] = MFMA16(afr, bfr, cst[mi]); } }
#pragma unroll
        for (int mi = 0; mi < 8; ++mi) { v2u o; o.x = pk2_sw(cst[mi][0], cst[mi][1]); o.y = pk2_sw(cst[mi][2], cst[mi][3]); *(LAS v2u*)(sCT + (16 * wave + r16) * 136 + 16 * mi + 4 * quad) = o; }
        if (tid < 128) { float s = 0.f;
#pragma unroll 8
            for (int t = 0; t < 64; ++t) s += bf2f(sK[t * 136 + tid]) * sWK[t];
            sN[tid] = dec * sN[tid] + s; } }
#pragma unroll
    for (int rg = 0; rg < 4; ++rg) { const int to = 16 * tt + 4 * quad + rg; const float rn = rsqrtf((sSS[to] + sSS[64 + to]) * (1.f / 128.f) + EPS);
#pragma unroll
        for (int nv = 0; nv < 4; ++nv) { const int dv = 16 * (4 * dh + nv) + r16; const float og = bf2f(ogr[rg][nv]); const float sg = 1.0f / (1.0f + __expf(-og));
            U[(size_t)(row0 + to) * DM + h * 128 + dv] = (bf16)f2bf(acc[nv][rg] * rn * p.in[13][h * 128 + dv] * sg); } }
    __syncthreads();
    }
#undef OUT_LOAD
    }
}

template <int K>
__device__ __forceinline__ void sample_gemm_piece(LAS unsigned char* L, const bf16* A, const bf16* Bt, bf16* Yo, int piece) {
    const int tid = tid_fresh(), lane = tid & 63, wave = tid >> 6, r16 = lane & 15, quad = lane >> 4;
    const int mrow0 = (piece >> 4) * 32, ncol0 = (piece & 15) * 64; constexpr int KW = K / 8, NK = KW / 32;
    f32x4 acc[2][4];
#pragma unroll
    for (int mi = 0; mi < 2; ++mi)
#pragma unroll
        for (int ni = 0; ni < 4; ++ni) acc[mi][ni] = (f32x4){0.f, 0.f, 0.f, 0.f};
    const bf16* ap = A + (size_t)(mrow0 + r16) * K + wave * KW + 8 * quad; const bf16* bp = Bt + (size_t)(ncol0 + r16) * K + wave * KW + 8 * quad;
#pragma unroll
    for (int ks = 0; ks < NK; ++ks) { bf16x8 a[2], b[4];
#pragma unroll
        for (int mi = 0; mi < 2; ++mi) a[mi] = *(const bf16x8*)(ap + (size_t)(16 * mi) * K + 32 * ks);
#pragma unroll
        for (int ni = 0; ni < 4; ++ni) b[ni] = *(const bf16x8*)(bp + (size_t)(16 * ni) * K + 32 * ks);
#pragma unroll
        for (int mi = 0; mi < 2; ++mi)
#pragma unroll
            for (int ni = 0; ni < 4; ++ni) acc[mi][ni] = MFMA16(a[mi], b[ni], acc[mi][ni]); }
    LAS float* red = (LAS float*)L + wave * 2048;
#pragma unroll
    for (int mi = 0; mi < 2; ++mi)
#pragma unroll
        for (int ni = 0; ni < 4; ++ni)
#pragma unroll
            for (int rg = 0; rg < 4; ++rg) red[(16 * mi + 4 * quad + rg) * 64 + 16 * ni + r16] = acc[mi][ni][rg];
    __syncthreads();
    { const int row = tid >> 4, c4 = (tid & 15) * 4; f32x4 s = {0.f, 0.f, 0.f, 0.f};
#pragma unroll
        for (int w = 0; w < 8; ++w) s += *(const LAS f32x4*)((LAS float*)L + w * 2048 + row * 64 + c4);
        v2u o; o.x = pk2(s[0], s[1]); o.y = pk2(s[2], s[3]); *(v2u*)(Yo + (size_t)(mrow0 + row) * DM + ncol0 + c4) = o; }
    __syncthreads();
}

template <class Epi>
__device__ __forceinline__ void run_gemm(LAS unsigned char* L, const bf16* A, const bf16* Bt, int M, int N, int K, const Epi& E) {
    pg8::Gemm g{A, Bt, M, N, K}; pg8::StaticOrder S; S.init(M, N, (int)gridDim.x, (int)blockIdx.x);
    pg8::gemm_phase<Epi, pg8::StaticOrder, true, true>((PG8_LAS unsigned char*)L, g, S, E);
}

__global__ void __launch_bounds__(512, 2) fwd_megakernel(Params p) {
    extern __shared__ __attribute__((aligned(16))) unsigned char lds_raw[];
    LAS unsigned char* L = (LAS unsigned char*)lds_raw;
    cg::grid_group grid = cg::this_grid();
    unsigned char* ws = p.ws;
    bf16* XN = (bf16*)(ws + WS_XN); bf16* HZ = (bf16*)(ws + WS_HZ); bf16* Y = (bf16*)(ws + WS_Y);
    const int G = gridDim.x, bx = blockIdx.x;

    if (threadIdx.x < 8) ((LAS unsigned*)(L + 131072))[threadIdx.x] = 0u;
    __syncthreads();
    const XcdBarrier bar = xcd_barrier_post((unsigned*)(ws + WS_CTL), (volatile LAS unsigned*)(L + 131072));
    if (p.out == nullptr) grid.sync();
    prologue(p, L);
    xcd_barrier(bar);
    { pg8::EpiSwiglu E{HZ, DFF}; run_gemm(L, XN, (const bf16*)(ws + WS_WGU1), NROWS, 2 * DFF, DM, E); }
    { const int rem = 1452 % G; if (rem != 0 && bx >= rem) conv_tail_a(p, L, bx - rem, G - rem); else if (rem == 0) conv_tail_a(p, L, bx, G); }
    xcd_barrier(bar);
    { pg8::EpiBf16<0> E{Y, DM, nullptr, 0, 0, 1.f}; run_gemm(L, HZ, (const bf16*)(ws + WS_WD1), NP, DM, DFF, E); }
    for (int pc = bx; pc < 256; pc += G) sample_gemm_piece<DFF>(L, HZ + (size_t)NP * DFF, (const bf16*)(ws + WS_WD1), Y + (size_t)NP * DM, pc);
    xcd_barrier(bar);
    row_pass<false, false, true>(p, L, 0.5f, 1, 2, XN, (bf16*)p.out, (const float*)(ws + WS_RS) + 2 * NROWS, (float*)(ws + WS_RS));
    xcd_barrier(bar);
    { pg8::EpiBf16<0> E{HZ, ZW, nullptr, 0, 0, 1.f}; run_gemm(L, (const bf16*)p.out, (const bf16*)(ws + WS_WIN), NROWS, ZW, DM, E); }
    if (bx >= G - 8) stats_item(p, L, bx - (G - 8));
    xcd_barrier(bar);
    mlstm_dcs_phase(p, L);
    for (int it = bx; it < 256; it += G) swa_prompt_item(p, L, it);
    for (int it = bx; it < 512; it += G) mlstm_sample_item(p, L, it);
    for (int it = bx; it < 256; it += G) swa_sample_item(p, L, it);
    xcd_barrier(bar);
    scan_phase(p, L);
    xcd_barrier(bar);
    mlstm_out_phase(p, L);
    xcd_barrier(bar);
    { pg8::EpiBf16<0> E{Y, DM, nullptr, 0, 0, 1.f}; run_gemm(L, XN, (const bf16*)(ws + WS_WOUT), NP, DM, DM, E); }
    for (int pc = bx; pc < 256; pc += G) sample_gemm_piece<DM>(L, XN + (size_t)NP * DM, (const bf16*)(ws + WS_WOUT), Y + (size_t)NP * DM, pc);
    xcd_barrier(bar);
    row_pass<false, false, false>(p, L, 1.0f, 3, 4, (const bf16*)p.out, (bf16*)(ws + WS_CT), (const float*)(ws + WS_RS), (float*)(ws + WS_RS) + NROWS);
    xcd_barrier(bar);
    { pg8::EpiSwiglu E{HZ, DFF}; run_gemm(L, (const bf16*)(ws + WS_CT), (const bf16*)(ws + WS_WGU2), NROWS, 2 * DFF, DM, E); }
    xcd_barrier(bar);
    { pg8::EpiBf16<0> E{Y, DM, nullptr, 0, 0, 1.f}; run_gemm(L, HZ, (const bf16*)(ws + WS_WD2), NP, DM, DFF, E); }
    for (int pc = bx; pc < 256; pc += G) sample_gemm_piece<DFF>(L, HZ + (size_t)NP * DFF, (const bf16*)(ws + WS_WD2), Y + (size_t)NP * DM, pc);
    xcd_barrier(bar);
    row_pass<false, true, false>(p, L, 0.5f, 5, 5, (const bf16*)(ws + WS_CT), nullptr, (const float*)(ws + WS_RS) + NROWS, nullptr);
}

extern "C" void kernel_launch(void* const* d_in, const int* in_sizes, int n_in, void* d_out, int out_size, void* d_ws, size_t ws_size, hipStream_t stream) {
    static int grid = 0;
    if (grid == 0) {
        int dev = 0, cus = 0, per_cu = 0;
        hipGetDevice(&dev);
        hipDeviceGetAttribute(&cus, hipDeviceAttributeMultiprocessorCount, dev);
        hipFuncSetAttribute((const void*)fwd_megakernel, hipFuncAttributeMaxDynamicSharedMemorySize, LDS_BYTES);
        hipOccupancyMaxActiveBlocksPerMultiprocessor(&per_cu, (const void*)fwd_megakernel, 512, LDS_BYTES);
        if (per_cu < 1) { fprintf(stderr, "kernel_launch: occupancy query returned %d\n", per_cu); per_cu = 1; }
        (void)hipGetLastError();
        grid = cus * 1;
        if (n_in != 16 || ws_size < 240 * MiB) fprintf(stderr, "kernel_launch: unexpected n_in %d / ws %zu\n", n_in, ws_size);
    }
    Params p{};
    for (int i = 0; i < 16; ++i) p.in[i] = (const float*)d_in[i];
    p.out = (float*)d_out; p.ws = (unsigned char*)d_ws;
    (void)hipMemsetAsync((unsigned char*)d_ws + WS_CTL, 0, 16384, stream);
    void* args[] = {&p};
    hipError_t e = hipLaunchCooperativeKernel((const void*)fwd_megakernel, dim3(grid), dim3(512), args, LDS_BYTES, stream);
    if (e != hipSuccess) fprintf(stderr, "cooperative launch failed: %s (grid %d)\n", hipGetErrorString(e), grid);
}
```

```cpp
#include <hip/hip_runtime.h>
#include <hip/hip_cooperative_groups.h>
#include <cstdio>
#include <cstdint>
namespace cg = cooperative_groups;
__device__ __forceinline__ int tid_fresh() { int t = threadIdx.x; asm volatile("" : "+v"(t)); return t; }
namespace pg8 {
#define PG8_LAS __attribute__((address_space(3)))
typedef unsigned short bf16_t;
typedef short bf16x8 __attribute__((ext_vector_type(8)));
typedef float f32x4 __attribute__((ext_vector_type(4)));
typedef unsigned u32x4 __attribute__((ext_vector_type(4)));
constexpr int BM = 256, BK = 64, HALF = 128, HTB = HALF * BK * 2  , STAGE_BYTES = 8 * HTB, NXCD = 8, WGM = 8;

__host__ __device__ __forceinline__ int lds_byte(int r, int c) { const int st = (r >> 4) * 2 + (c >> 5), rr = r & 15, cc = c & 31, ob = rr * 64 + cc * 2; return st * 1024 + (ob ^ (((ob >> 9) & 1) << 5)); }
__host__ __device__ __forceinline__ void stage_rc(int b, int& R, int& C) { const int st = b / 1024, sb = b % 1024, swz = sb ^ (((sb >> 9) & 1) << 5); R = (st >> 1) * 16 + swz / 64; C = (st & 1) * 32 + (swz % 64) / 2; }
__host__ __device__ __forceinline__ int perm32(int rho) { const int n = rho >> 4, i = rho & 15; return 8 * (i >> 2) + 4 * n + (i & 3); }

struct Unit { int pm, pn; };
struct Gemm { const bf16_t* A; const bf16_t* Bt; int M, N, K; };

struct StaticOrder {
    int nM, nN, nwg, G, c;
    __host__ __device__ void init(int M, int N, int G_, int c_) { nM = M / BM; nN = N / BM; nwg = nM * nN; G = G_; c = c_; }
    __host__ __device__ bool next(int i, Unit& u) const {
        const long L = (long)i * G + c; if (L >= nwg) return false;
        int wgid = (int)L; { const int q = nwg / NXCD, r = nwg % NXCD, xcd = wgid % NXCD, off = wgid / NXCD; wgid = (xcd < r ? xcd * (q + 1) : r * (q + 1) + (xcd - r) * q) + off; }
        const int nig = WGM * nN, gid = wgid / nig, fm = gid * WGM, gsz = (nM - fm) < WGM ? (nM - fm) : WGM;
        u.pm = fm + ((wgid % nig) % gsz); u.pn = (wgid % nig) / gsz; return true;
    }
    __device__ __forceinline__ void a_ready(const Unit&) const {}
    __device__ __forceinline__ void done(const Unit&) const {}
};

__device__ __forceinline__ unsigned cvt_pk_bf16(float lo, float hi) { unsigned r; asm volatile("v_cvt_pk_bf16_f32 %0, %1, %2" : "=v"(r) : "v"(lo), "v"(hi)); return r; }
typedef float f32x2 __attribute__((ext_vector_type(2)));
__device__ __forceinline__ f32x2 gelu_pk(f32x2 v) {
    const f32x2 av = __builtin_elementwise_abs(v), d = av * 0.2316418882f + 1.0f;
    f32x2 t; t.x = __builtin_amdgcn_rcpf(d.x); t.y = __builtin_amdgcn_rcpf(d.y);
    f32x2 q = t * 0.5307027145f + (-0.7265760135f); q = q * t + 0.7107068705f; q = q * t + (-0.142248368f); q = q * t + 0.127414796f; q = q * t;
    const f32x2 s = (v * v) * (-0.72134752044f);
    f32x2 e; e.x = __builtin_amdgcn_exp2f(s.x); e.y = __builtin_amdgcn_exp2f(s.y);
    const f32x2 m = v * (q * e), r = v - m;
    f32x2 o; o.x = v.x < 0.f ? m.x : r.x; o.y = v.y < 0.f ? m.y : r.y; return o;
}

template <int ACT  > struct EpiBf16 {
    static constexpr bool PERM = true, AFTER_DRAIN = false; static_assert(ACT == 0 || ACT == 1, "EpiBf16: ACT is 0 (none) or 1 (gelu_pk)");
    bf16_t* O; int ldc; const float* bias; int split_cols; size_t split_stride; float scale0;
    __device__ __forceinline__ void operator()(const f32x4 (&acc)[2][2][4][2], const Unit& u, int wr, int wc, int fr, int fq) const {
        const int row0 = u.pm * BM + wr * 64 + fr; int colt = u.pn * BM; bf16_t* base = O;
        float sc = 1.f; if (split_cols) { const int t = colt / split_cols; base += (size_t)t * split_stride; colt -= t * split_cols; if (t == 0) sc = scale0; }
        const int col0 = colt + wc * 32 + 8 * fq, bcol0 = u.pn * BM + wc * 32 + 8 * fq;
        f32x4 bv[2][2];
#pragma unroll
        for (int bj = 0; bj < 2; ++bj)
#pragma unroll
            for (int n = 0; n < 2; ++n) bv[bj][n] = bias ? *(const f32x4*)(bias + bcol0 + bj * HALF + 4 * n) : (f32x4){0.f, 0.f, 0.f, 0.f};
#pragma unroll
        for (int ai = 0; ai < 2; ++ai)
#pragma unroll
            for (int m = 0; m < 4; ++m) { bf16_t* rowp = base + (size_t)(row0 + ai * HALF + m * 16) * ldc + col0;
#pragma unroll
                for (int bj = 0; bj < 2; ++bj) { f32x4 v0 = acc[ai][bj][m][0] + bv[bj][0], v1 = acc[ai][bj][m][1] + bv[bj][1];
                    if (ACT == 1) { f32x2 a = gelu_pk((f32x2){v0[0], v0[1]}), b = gelu_pk((f32x2){v0[2], v0[3]}), c = gelu_pk((f32x2){v1[0], v1[1]}), d = gelu_pk((f32x2){v1[2], v1[3]});
                        v0 = (f32x4){a.x, a.y, b.x, b.y}; v1 = (f32x4){c.x, c.y, d.x, d.y}; }
                    v0 = v0 * sc; v1 = v1 * sc; u32x4 w; w.x = cvt_pk_bf16(v0[0], v0[1]); w.y = cvt_pk_bf16(v0[2], v0[3]); w.z = cvt_pk_bf16(v1[0], v1[1]); w.w = cvt_pk_bf16(v1[2], v1[3]);
                    *(u32x4*)(rowp + bj * HALF) = w; } }
    }
};
template <class Epi, class Sched, bool ALIGN_EPI = false, bool SP2 = false>
__device__ __forceinline__ void gemm_phase(PG8_LAS unsigned char* lds, const Gemm g, const Sched& S, const Epi& E) {
    const int tid = tid_fresh(), wid = __builtin_amdgcn_readfirstlane(tid >> 6), lane = tid & 63, wr = wid >> 2, wc = wid & 3, fr = lane & 15, fq = lane >> 4;
    const int K = g.K, nt = K / BK;
    unsigned voffA[2], voffB[2];
#pragma unroll
    for (int i = 0; i < 2; ++i) { int R, C; stage_rc(tid * 16 + i * 8192, R, C); const int Rb = Epi::PERM ? ((R & ~31) + perm32(R & 31)) : R;
        voffA[i] = (unsigned)(R * K + C) * 2u; voffB[i] = (unsigned)(Rb * K + C) * 2u; }
    const size_t kstep = (size_t)(BK * 2);
    const size_t hstep = (size_t)HALF * K * 2;
    const size_t tstep = 2 * hstep;
    const unsigned ldsw = (unsigned)wid * 1024u;
    const int aoff = lds_byte(wr * 64 + fr, fq * 8), boff = lds_byte(wc * 32 + fr, fq * 8);
#define PG8_SA(b, h) (((b) * 2 + (h)) * HTB)
#define PG8_SB(b, h) ((4 + (b) * 2 + (h)) * HTB)
#define PG8_STAGE(bufoff, gbase, voff) do { _Pragma("unroll") for (int _i = 0; _i < 2; ++_i) \
        __builtin_amdgcn_global_load_lds((const unsigned*)((const char*)(gbase) + (voff)[_i]), (PG8_LAS unsigned*)(lds + (bufoff) + ldsw + _i * 8192), 16, 0, 0); } while (0)
#define PG8_LDA(dst, b, h) do { _Pragma("unroll") for (int m = 0; m < 4; ++m) _Pragma("unroll") for (int k = 0; k < 2; ++k) dst[m][k] = *(const PG8_LAS bf16x8*)(lds + PG8_SA(b, h) + aoff + m * 2048 + k * 1024); } while (0)
#define PG8_LDB(dst, b, h) do { _Pragma("unroll") for (int n = 0; n < 2; ++n) _Pragma("unroll") for (int k = 0; k < 2; ++k) dst[n][k] = *(const PG8_LAS bf16x8*)(lds + PG8_SB(b, h) + boff + n * 2048 + k * 1024); } while (0)
#define PG8_MMA(ai, bj, At, Bt) do { __builtin_amdgcn_s_setprio(1); _Pragma("unroll") for (int m = 0; m < 4; ++m) _Pragma("unroll") for (int n = 0; n < 2; ++n) _Pragma("unroll") for (int k = 0; k < 2; ++k) \
        acc[ai][bj][m][n] = __builtin_amdgcn_mfma_f32_16x16x32_bf16(Bt[n][k], At[m][k], acc[ai][bj][m][n], 0, 0, 0); __builtin_amdgcn_s_setprio(0); } while (0)
#define PG8_WAIT_V(n) asm volatile("s_waitcnt vmcnt(" #n ")" ::: "memory")
#define PG8_WAIT_L(n) asm volatile("s_waitcnt lgkmcnt(" #n ")" ::: "memory")
#define PG8_BAR __builtin_amdgcn_s_barrier()
#define PG8_SCHED __builtin_amdgcn_sched_barrier(0)
    Unit cur, nxt; int ui = 0;
    if (!S.next(0, cur)) return;
    f32x4 acc[2][2][4][2];
#pragma unroll
    for (int a = 0; a < 2; ++a)
#pragma unroll
        for (int b = 0; b < 2; ++b)
#pragma unroll
            for (int m = 0; m < 4; ++m)
#pragma unroll
                for (int n = 0; n < 2; ++n) acc[a][b][m][n] = (f32x4){0.f, 0.f, 0.f, 0.f};
    bf16x8 At[4][2], B0[2][2], B1[2][2];
    const char* cA = (const char*)g.A + (size_t)cur.pm * tstep; const char* cB = (const char*)g.Bt + (size_t)cur.pn * tstep;
    S.a_ready(cur);
    if constexpr (SP2) {
        PG8_STAGE(PG8_SB(0, 0), cB, voffB); PG8_STAGE(PG8_SB(0, 1), cB + hstep, voffB); PG8_STAGE(PG8_SA(0, 0), cA, voffA); PG8_STAGE(PG8_SA(0, 1), cA + hstep, voffA);
        if (wr == 1) PG8_BAR;
        PG8_WAIT_V(2); PG8_BAR;
        PG8_STAGE(PG8_SB(1, 0), cB + kstep, voffB); PG8_STAGE(PG8_SA(1, 0), cA + kstep, voffA); PG8_STAGE(PG8_SB(1, 1), cB + hstep + kstep, voffB);
        PG8_WAIT_V(6); PG8_BAR;
    } else {
        PG8_STAGE(PG8_SB(0, 0), cB, voffB); PG8_STAGE(PG8_SA(0, 0), cA, voffA); PG8_STAGE(PG8_SB(0, 1), cB + hstep, voffB); PG8_STAGE(PG8_SA(0, 1), cA + hstep, voffA);
        if (wr == 1) PG8_BAR;
        PG8_WAIT_V(4); PG8_BAR;
        PG8_STAGE(PG8_SB(1, 0), cB + kstep, voffB); PG8_STAGE(PG8_SA(1, 0), cA + kstep, voffA); PG8_STAGE(PG8_SB(1, 1), cB + hstep + kstep, voffB);
        PG8_WAIT_V(6); PG8_BAR;
    }
    for (;;) {
        const bool has_next = S.next(ui + 1, nxt);
        const char* nA = has_next ? (const char*)g.A + (size_t)nxt.pm * tstep : cA; const char* nB = has_next ? (const char*)g.Bt + (size_t)nxt.pn * tstep : cB;
        for (int t = 0; t < nt; t += 2) {
            const bool last = (t == nt - 2);
            const char* a1 = cA + (size_t)(t + 1) * kstep;
            const char* a2 = last ? nA : cA + (size_t)(t + 2) * kstep; const char* b2 = last ? nB : cB + (size_t)(t + 2) * kstep;
            const char* a3 = a2 + kstep; const char* b3 = b2 + kstep;
            if (last && has_next) S.a_ready(nxt);
            if constexpr (SP2) {
            PG8_LDB(B0, 0, 0); PG8_LDB(B1, 0, 1); PG8_SCHED; PG8_LDA(At, 0, 0); PG8_STAGE(PG8_SA(1, 1), a1 + hstep, voffA);
            PG8_WAIT_V(8); PG8_WAIT_L(0); PG8_BAR; PG8_MMA(0, 0, At, B0); PG8_MMA(0, 1, At, B1); PG8_BAR; PG8_SCHED;
            PG8_LDA(At, 0, 1); PG8_STAGE(PG8_SB(0, 0), b2, voffB); PG8_STAGE(PG8_SB(0, 1), b2 + hstep, voffB); PG8_STAGE(PG8_SA(0, 0), a2, voffA);
            PG8_WAIT_V(8); PG8_WAIT_L(0); PG8_BAR; PG8_MMA(1, 0, At, B0); PG8_MMA(1, 1, At, B1); PG8_BAR; PG8_SCHED;
            PG8_LDB(B0, 1, 0); PG8_LDB(B1, 1, 1); PG8_SCHED; PG8_LDA(At, 1, 0); PG8_STAGE(PG8_SA(0, 1), a2 + hstep, voffA);
            PG8_WAIT_V(8); PG8_WAIT_L(0); PG8_BAR; PG8_MMA(0, 0, At, B0); PG8_MMA(0, 1, At, B1); PG8_BAR; PG8_SCHED;
            PG8_LDA(At, 1, 1); PG8_STAGE(PG8_SB(1, 0), b3, voffB); PG8_STAGE(PG8_SB(1, 1), b3 + hstep, voffB); PG8_STAGE(PG8_SA(1, 0), a3, voffA);
            PG8_WAIT_V(8); PG8_WAIT_L(0); PG8_BAR; PG8_MMA(1, 0, At, B0); PG8_MMA(1, 1, At, B1); PG8_BAR; PG8_SCHED;
            } else {
            PG8_LDB(B0, 0, 0); PG8_SCHED; PG8_LDA(At, 0, 0); PG8_STAGE(PG8_SA(1, 1), a1 + hstep, voffA);
            PG8_WAIT_L(8); PG8_BAR; PG8_WAIT_L(0); PG8_MMA(0, 0, At, B0); PG8_BAR; PG8_SCHED;
            PG8_LDB(B1, 0, 1); PG8_STAGE(PG8_SB(0, 0), b2, voffB);
            PG8_BAR; PG8_WAIT_L(0); PG8_MMA(0, 1, At, B1); PG8_BAR;
            PG8_LDA(At, 0, 1); PG8_STAGE(PG8_SA(0, 0), a2, voffA);
            PG8_BAR; PG8_WAIT_L(0); PG8_MMA(1, 0, At, B0); PG8_BAR; PG8_SCHED;
            PG8_STAGE(PG8_SB(0, 1), b2 + hstep, voffB);
            PG8_WAIT_V(6); PG8_BAR; PG8_MMA(1, 1, At, B1); PG8_BAR;
            PG8_LDB(B0, 1, 0); PG8_SCHED; PG8_LDA(At, 1, 0); PG8_STAGE(PG8_SA(0, 1), a2 + hstep, voffA);
            PG8_WAIT_L(8); PG8_BAR; PG8_WAIT_L(0); PG8_MMA(0, 0, At, B0); PG8_BAR; PG8_SCHED;
            PG8_LDB(B1, 1, 1); PG8_STAGE(PG8_SB(1, 0), b3, voffB);
            PG8_BAR; PG8_WAIT_L(0); PG8_MMA(0, 1, At, B1); PG8_BAR;
            PG8_LDA(At, 1, 1); PG8_STAGE(PG8_SA(1, 0), a3, voffA);
            PG8_BAR; PG8_WAIT_L(0); PG8_MMA(1, 0, At, B0); PG8_BAR; PG8_SCHED;
            PG8_STAGE(PG8_SB(1, 1), b3 + hstep, voffB);
            PG8_WAIT_V(6); PG8_BAR; PG8_MMA(1, 1, At, B1); PG8_BAR;
            }
        }
        if constexpr (ALIGN_EPI) { if (wr == 0) PG8_BAR; }
        if constexpr (!Epi::AFTER_DRAIN) { E(acc, cur, wr, wc, fr, fq); S.done(cur); }
        if (!has_next) break;
#pragma unroll
        for (int a = 0; a < 2; ++a)
#pragma unroll
            for (int b = 0; b < 2; ++b)
#pragma unroll
                for (int m = 0; m < 4; ++m)
#pragma unroll
                    for (int n = 0; n < 2; ++n) acc[a][b][m][n] = (f32x4){0.f, 0.f, 0.f, 0.f};
        cur = nxt; cA = nA; cB = nB; ++ui;
        if constexpr (ALIGN_EPI) { if (wr == 1) PG8_BAR; }
    }
    PG8_WAIT_V(0);
    if constexpr (!ALIGN_EPI) { if (wr == 0) PG8_BAR; }
    PG8_BAR;
    if constexpr (Epi::AFTER_DRAIN) { E.fused(acc, cur, wr, wc, fr, fq, lds, wid, lane); S.done(cur); }
#undef PG8_SA
#undef PG8_SB
#undef PG8_STAGE
#undef PG8_LDA
#undef PG8_LDB
#undef PG8_MMA
#undef PG8_WAIT_V
#undef PG8_WAIT_L
#undef PG8_BAR
#undef PG8_SCHED
}
}

namespace pg8 {
struct EpiSwiglu {
    static constexpr bool PERM = true, AFTER_DRAIN = false;
    bf16_t* O; int ldc;
    __device__ __forceinline__ void operator()(const f32x4 (&acc)[2][2][4][2], const Unit& u, int wr, int wc, int fr, int fq) const {
        const int row0 = u.pm * BM + wr * 64 + fr; const int col0 = u.pn * HALF + wc * 32 + 8 * fq;
#pragma unroll
        for (int ai = 0; ai < 2; ++ai)
#pragma unroll
            for (int m = 0; m < 4; ++m) { bf16_t* rowp = O + (size_t)(row0 + ai * HALF + m * 16) * ldc + col0;
                float hv[8];
#pragma unroll
                for (int n = 0; n < 2; ++n)
#pragma unroll
                    for (int i = 0; i < 4; ++i) { const float g = acc[ai][0][m][n][i], up = acc[ai][1][m][n][i];
                        hv[n * 4 + i] = g * __builtin_amdgcn_rcpf(1.0f + __expf(-g)) * up; }
                u32x4 w; w.x = cvt_pk_bf16(hv[0], hv[1]); w.y = cvt_pk_bf16(hv[2], hv[3]); w.z = cvt_pk_bf16(hv[4], hv[5]); w.w = cvt_pk_bf16(hv[6], hv[7]);
                *(u32x4*)rowp = w; }
    }
};
}

#define LAS __attribute__((address_space(3)))
typedef unsigned short bf16;
typedef float f32x4 __attribute__((ext_vector_type(4)));
typedef short bf16x8 __attribute__((ext_vector_type(8)));
typedef short bf16x4 __attribute__((ext_vector_type(4)));
typedef unsigned v4u __attribute__((ext_vector_type(4)));
typedef unsigned v2u __attribute__((ext_vector_type(2)));

#define XB_TMO      128
#define XB_XCNT(j)  (256  + 64 * (j))
#define XB_XSUB(j)  (1280 + 64 * (j))
#define XB_XGEN(j)  (2304 + 64 * (j))
#define XB_TOP      3328
#define XB_TOPGEN   3392
#define XCD_BAR_WORDS 3456
#define XB_SPIN_CAP (1u << 18)

__device__ __forceinline__ unsigned xb_ld(unsigned* p)              { return __hip_atomic_load(p, __ATOMIC_RELAXED, __HIP_MEMORY_SCOPE_AGENT); }
__device__ __forceinline__ unsigned xb_add(unsigned* p, unsigned v) { return __hip_atomic_fetch_add(p, v, __ATOMIC_RELAXED, __HIP_MEMORY_SCOPE_AGENT); }
__device__ __forceinline__ unsigned xb_xcc_id() { return (unsigned)__builtin_amdgcn_s_getreg((3 << 11) | 20) & 0xFu; }
#define XB_SPIN(cond, bar) do { unsigned _sp = 0; while (cond) { __builtin_amdgcn_s_sleep(1); \
    if ((++_sp & 255u) == 0u) { if (xb_ld(&(bar)[XB_TMO])) break; if (_sp > XB_SPIN_CAP) { atomicAdd(&(bar)[XB_TMO], 1u); break; } } } } while (0)

struct XcdBarrier {
    unsigned* bar; unsigned x;
    volatile LAS unsigned* st;
};

__device__ __forceinline__ XcdBarrier xcd_barrier_post(unsigned* bar, volatile LAS unsigned* st) {
    XcdBarrier b; b.bar = bar; b.x = xb_xcc_id(); b.st = st;
    if (threadIdx.x == 0) (void)xb_add(&bar[XB_XCNT(b.x)], 1u);
    return b;
}
__device__ __forceinline__ void xcd_barrier_complete(unsigned* bar, unsigned x, unsigned& nloc, unsigned& nx) {
    const unsigned G = gridDim.x * gridDim.y * gridDim.z;
    unsigned sum, cnt, mine, sp = 0u;
    for (;;) {
        sum = 0u; cnt = 0u; mine = 0u;
#pragma unroll
        for (unsigned j = 0; j < 16; ++j) { const unsigned c = xb_ld(&bar[XB_XCNT(j)]); sum += c; cnt += (c > 0u) ? 1u : 0u; mine = (j == x) ? c : mine; }
        if (sum == G) break;
        __builtin_amdgcn_s_sleep(1);
        if ((++sp & 255u) == 0u) { if (xb_ld(&bar[XB_TMO])) break; if (sp > XB_SPIN_CAP) { atomicAdd(&bar[XB_TMO], 1u); break; } }
    }
    nloc = mine > 0u ? mine : 1u; nx = cnt > 0u ? cnt : 1u;
}

__device__ __forceinline__ void xcd_barrier(const XcdBarrier& b) {
    asm volatile("s_waitcnt vmcnt(0)" ::: "memory");
    __syncthreads();
    if (threadIdx.x == 0) {
        unsigned* bar = b.bar;
        __builtin_amdgcn_s_waitcnt(0);
        unsigned nloc = b.st[0], nx = b.st[1];
        if (nloc == 0u) { xcd_barrier_complete(bar, b.x, nloc, nx); b.st[0] = nloc; b.st[1] = nx; }
        const unsigned old = xb_add(&bar[XB_XSUB(b.x)], 1u);
        const unsigned gen = old / nloc;
        if (old + 1u == (gen + 1u) * nloc) {
            __builtin_amdgcn_fence(__ATOMIC_RELEASE, "agent");
            asm volatile("s_waitcnt vmcnt(0)" ::: "memory");
            const unsigned og = xb_add(&bar[XB_TOP], 1u);
            const unsigned tg = og / nx;
            if (og + 1u == (tg + 1u) * nx) xb_add(&bar[XB_TOPGEN], 1u);
            else XB_SPIN(xb_ld(&bar[XB_TOPGEN]) == tg, bar);
            __builtin_amdgcn_fence(__ATOMIC_ACQUIRE, "agent");
            xb_add(&bar[XB_XGEN(b.x)], 1u);
            asm volatile("s_waitcnt vmcnt(0)" ::: "memory");
        } else {
            XB_SPIN(xb_ld(&bar[XB_XGEN(b.x)]) == gen, bar);
            __builtin_amdgcn_fence(__ATOMIC_ACQUIRE, "agent");
            asm volatile("s_waitcnt vmcnt(0)" ::: "memory");
        }
    }
    __syncthreads();
}

constexpr int NROWS = 16896, NP = 16384, DM = 1024, DFF = 2816, ZW = 2816;
constexpr float EPS = 1e-6f;
constexpr size_t MiB = 1u << 20;
constexpr size_t WS_WGU1 = 0, WS_WD1 = 11 * MiB, WS_WIN = 17 * MiB, WS_WOUT = 23 * MiB, WS_WGU2 = 25 * MiB, WS_WD2 = 36 * MiB;
constexpr size_t WS_XN = 42 * MiB, WS_HZ = 75 * MiB, WS_Y = 166 * MiB, WS_CT = 199 * MiB, WS_NB = 231 * MiB, WS_GATES = 232 * MiB, WS_MST = 233 * MiB, WS_DEC = WS_MST + 65536, WS_CTL = 234 * MiB, WS_RS = 236 * MiB  ;
constexpr size_t O_YS = 16777216, O_PSK = 17301504, O_PSV = 17334272, O_PC = 17367040, O_PN = 17498112, O_PM = 17499136,
                 O_SSK = 17499144, O_SSV = 19596296, O_SC = 21693448, O_SN = 30082056, O_SM = 30147592;
constexpr int LDS_BYTES = 131072 + 1024;

struct Params { const float* in[16]; float* out; unsigned char* ws; };

__device__ __forceinline__ unsigned f2bf_sw(float f) { unsigned u = __builtin_bit_cast(unsigned, f); return (u + 0x7fffu + ((u >> 16) & 1u)) >> 16; }
__device__ __forceinline__ unsigned pk2_sw(float lo, float hi) { return f2bf_sw(lo) | (f2bf_sw(hi) << 16); }
__device__ __forceinline__ unsigned pk2(float lo, float hi) { unsigned r; asm("s_nop 0\n\tv_cvt_pk_bf16_f32 %0, %1, %2\n\ts_nop 1" : "=v"(r) : "v"(lo), "v"(hi)); return r; }
__device__ __forceinline__ unsigned f2bf(float f) { return pk2(f, 0.f) & 0xffffu; }
__device__ __forceinline__ float bf2f(unsigned b) { return __builtin_bit_cast(float, b << 16); }
__device__ __forceinline__ float bflo(unsigned w) { return __builtin_bit_cast(float, w << 16); }
__device__ __forceinline__ float bfhi(unsigned w) { return __builtin_bit_cast(float, w & 0xffff0000u); }
#define DPP_F(v, ctrl) __builtin_bit_cast(float, __builtin_amdgcn_update_dpp(0, __builtin_bit_cast(int, (v)), (ctrl), 0xF, 0xF, true))
#define RDL_F(v, l) __builtin_bit_cast(float, __builtin_amdgcn_readlane(__builtin_bit_cast(int, (v)), (l)))
__device__ __forceinline__ float wave_sum(float v) {
    v += DPP_F(v, 0xB1); v += DPP_F(v, 0x4E); v += DPP_F(v, 0x141); v += DPP_F(v, 0x140);
    return (RDL_F(v, 0) + RDL_F(v, 16)) + (RDL_F(v, 32) + RDL_F(v, 48));
}
__device__ __forceinline__ float wave_max(float v) {
    v = fmaxf(v, DPP_F(v, 0xB1)); v = fmaxf(v, DPP_F(v, 0x4E)); v = fmaxf(v, DPP_F(v, 0x141)); v = fmaxf(v, DPP_F(v, 0x140));
    return fmaxf(fmaxf(RDL_F(v, 0), RDL_F(v, 16)), fmaxf(RDL_F(v, 32), RDL_F(v, 48)));
}
__device__ __forceinline__ float row16_sum(float v) { v += DPP_F(v, 0xB1); v += DPP_F(v, 0x4E); v += DPP_F(v, 0x141); v += DPP_F(v, 0x140); return v; }
__device__ __forceinline__ float row8_sum(float v) { v += DPP_F(v, 0xB1); v += DPP_F(v, 0x4E); v += DPP_F(v, 0x141); return v; }
#define DPP_FO(idv, v, ctrl, rm) __builtin_bit_cast(float, __builtin_amdgcn_update_dpp(__builtin_bit_cast(int, (float)(idv)), __builtin_bit_cast(int, (v)), (ctrl), (rm), 0xF, false))
__device__ __forceinline__ float scan_sum(float v, int lane) {
    v += DPP_FO(0.f, v, 0x111, 0xF); v += DPP_FO(0.f, v, 0x112, 0xF); v += DPP_FO(0.f, v, 0x114, 0xF); v += DPP_FO(0.f, v, 0x118, 0xF);
    v += DPP_FO(0.f, v, 0x142, 0xA); v += DPP_FO(0.f, v, 0x143, 0xC);
    return v;
}
__device__ __forceinline__ float scan_max(float v, int lane) {
    v = fmaxf(v, DPP_FO(-INFINITY, v, 0x111, 0xF)); v = fmaxf(v, DPP_FO(-INFINITY, v, 0x112, 0xF)); v = fmaxf(v, DPP_FO(-INFINITY, v, 0x114, 0xF)); v = fmaxf(v, DPP_FO(-INFINITY, v, 0x118, 0xF));
    v = fmaxf(v, DPP_FO(-INFINITY, v, 0x142, 0xA)); v = fmaxf(v, DPP_FO(-INFINITY, v, 0x143, 0xC));
    return v;
}
__device__ __forceinline__ float logsig(float x) { return fminf(x, 0.f) - __logf(1.0f + __expf(-fabsf(x))); }
__device__ __forceinline__ bf16x8 cat4(bf16x4 a, bf16x4 b) { bf16x8 r; r[0] = a[0]; r[1] = a[1]; r[2] = a[2]; r[3] = a[3]; r[4] = b[0]; r[5] = b[1]; r[6] = b[2]; r[7] = b[3]; return r; }
__device__ __forceinline__ bf16x8 pack8(f32x4 a, f32x4 b) {
    v4u w; w.x = pk2(a[0], a[1]); w.y = pk2(a[2], a[3]); w.z = pk2(b[0], b[1]); w.w = pk2(b[2], b[3]);
    return __builtin_bit_cast(bf16x8, w);
}
__device__ __forceinline__ bf16x8 tr_frag(const LAS bf16* a0, const LAS bf16* a1) {
    const bf16x4 lo = __builtin_amdgcn_ds_read_tr16_b64_v4i16((LAS bf16x4*)a0), hi = __builtin_amdgcn_ds_read_tr16_b64_v4i16((LAS bf16x4*)a1); return cat4(lo, hi); }
#define MFMA16(a, b, c) __builtin_amdgcn_mfma_f32_16x16x32_bf16((a), (b), (c), 0, 0, 0)
#define VELEM(v, e) (((v)[(e) >> 1] >> (16 * ((e) & 1))) & 0xffffu)

__device__ __forceinline__ void tr_item(const float* W, int ld, int k0, int ncol, bf16* WT, int K, int drow, float scale, const float* gk, LAS float* scr, int lane) {
#pragma unroll
    for (int i = 0; i < 32; ++i) { const int kk = 2 * i + (lane >> 5); scr[kk * 33 + (lane & 31)] = __builtin_nontemporal_load(&W[(size_t)(k0 + kk) * ld + ncol + (lane & 31)]) * scale; }
    asm volatile("s_waitcnt lgkmcnt(0)" ::: "memory");
    const int c = lane & 7;
    f32x4 ga = {1.f, 1.f, 1.f, 1.f}, gb = {1.f, 1.f, 1.f, 1.f}; if (gk) { ga = *(const f32x4*)(gk + k0 + 8 * c); gb = *(const f32x4*)(gk + k0 + 8 * c + 4); }
#pragma unroll
    for (int j = 0; j < 4; ++j) { const int n = (lane >> 3) + 8 * j; const LAS float* s = scr + (8 * c) * 33 + n;
        v4u o; o.x = pk2(s[0 * 33] * ga[0], s[1 * 33] * ga[1]); o.y = pk2(s[2 * 33] * ga[2], s[3 * 33] * ga[3]); o.z = pk2(s[4 * 33] * gb[0], s[5 * 33] * gb[1]); o.w = pk2(s[6 * 33] * gb[2], s[7 * 33] * gb[3]);
        *(v4u*)(WT + (size_t)(drow + n) * K + k0 + 8 * c) = o; }
    asm volatile("s_waitcnt lgkmcnt(0)" ::: "memory");
}

__device__ __forceinline__ void conv_item(const Params& p, LAS float* scr, int lane, int mat, int r) {
    unsigned char* ws = p.ws;
    const float* src; int ld, K, k0, ncol, drow; bf16* dst; float scale = 1.f;
    const float* gk = (mat == 0 || mat == 1) ? p.in[7] : (mat == 3 ? p.in[7] + 2 * DM : ((mat == 4 || mat == 5) ? p.in[7] + 4 * DM : nullptr));
    if (mat == 2 || mat == 6) { const int l = (mat == 6); const int kb = r >> 5, nb = r & 31; src = p.in[10] + (size_t)l * 2816 * 1024; ld = 1024; K = 2816; k0 = kb * 64; ncol = nb * 32; drow = ncol;
        dst = (bf16*)(ws + (l ? WS_WD2 : WS_WD1)); }
    else if (mat == 3) { const int kb = r / 88, nb = r - kb * 88; src = p.in[11]; ld = 2824; K = 1024; k0 = kb * 64; const int zc = nb * 32; ncol = zc + (zc >= 2048 ? 8 : 0); drow = zc; dst = (bf16*)(ws + WS_WIN);
        scale = (zc >= 512 && zc < 1024) ? 0.08838834764831845f : ((zc >= 2048 && zc < 2560) ? 0.125f : 1.f); }
    else if (mat == 7) { const int kb = r >> 5, nb = r & 31; src = p.in[15]; ld = 1024; K = 1024; k0 = kb * 64; ncol = nb * 32; drow = ncol; dst = (bf16*)(ws + WS_WOUT); }
    else { const int l = (mat >= 4), up = (mat & 1); const int kb = r / 88, nb = r - kb * 88; src = (up ? p.in[9] : p.in[8]) + (size_t)l * 1024 * 2816; ld = 2816; K = 1024; k0 = kb * 64; ncol = nb * 32;
        drow = 256 * (ncol >> 7) + (ncol & 127) + 128 * up; dst = (bf16*)(ws + (l ? WS_WGU2 : WS_WGU1)); }
    tr_item(src, ld, k0, ncol, dst, K, drow, scale, gk, scr, lane);
}
__device__ __forceinline__ void conv_tail_a(const Params& p, LAS unsigned char* L, int gwi, int ngwi) {
    const int tid = tid_fresh(), lane = tid & 63, wave = tid >> 6; LAS float* scr = (LAS float*)(L + wave * 16384);
    for (int it = gwi * 8 + wave; it < 3328; it += ngwi * 8) { if (it < 1408) conv_item(p, scr, lane, 3, it); else if (it < 2816) conv_item(p, scr, lane, 6, it - 1408); else conv_item(p, scr, lane, 7, it - 2816); }
    __syncthreads();
}

__device__ __forceinline__ void prologue(const Params& p, LAS unsigned char* L) {
    const int tid = tid_fresh(), lane = tid & 63, wave = tid >> 6;
    LAS float* scr = (LAS float*)(L + wave * 16384);
    const int gw = blockIdx.x * 8 + wave, NGW = gridDim.x * 8;
    unsigned char* ws = p.ws;
    for (int it = gw; it < 4224; it += NGW) { const int mat = it / 1408; conv_item(p, scr, lane, mat, it - mat * 1408); }
    const f32x4* g0 = (const f32x4*)(p.in[7]);
    f32x4 gv[4];
#pragma unroll
    for (int j = 0; j < 4; ++j) gv[j] = g0[64 * j + lane];
    bf16* XN = (bf16*)(ws + WS_XN);
    f32x4 v[4], vn[4];
#define PX_LOAD(R, V) do { const int r_ = (R); const float* xin = r_ < NP ? p.in[0] + (size_t)r_ * DM : p.in[1] + (size_t)(r_ - NP) * DM; _Pragma("unroll") for (int j = 0; j < 4; ++j) V[j] = __builtin_nontemporal_load(&((const f32x4*)xin)[64 * j + lane]); } while (0)
    PX_LOAD(gw < NROWS ? gw : 0, v);
    for (int r = gw; r < NROWS; r += NGW) {
        PX_LOAD((r + NGW) < NROWS ? (r + NGW) : r, vn);
        float ss = 0.f;
#pragma unroll
        for (int j = 0; j < 4; ++j) ss += (v[j][0] * v[j][0] + v[j][1] * v[j][1]) + (v[j][2] * v[j][2] + v[j][3] * v[j][3]);
        const float m0 = wave_sum(ss) * (1.f / DM) + EPS; const float rs = rsqrtf(m0);
        if (lane == 0) ((float*)(ws + WS_RS))[2 * NROWS + r] = sqrtf(m0);
        v2u* o = (v2u*)(XN + (size_t)r * DM);
#pragma unroll
        for (int j = 0; j < 4; ++j) { v2u w; w.x = pk2(v[j][0] * rs, v[j][1] * rs); w.y = pk2(v[j][2] * rs, v[j][3] * rs); o[64 * j + lane] = w; }
#pragma unroll
        for (int j = 0; j < 4; ++j) v[j] = vn[j];
    }
#undef PX_LOAD
}

template <bool FIRST, bool LAST, bool GATES>
__device__ __forceinline__ void row_pass(const Params& p, LAS unsigned char* L, float coef, int gpost, int gpre, const bf16* xb_in, bf16* xb_out, const float* ir_in, float* ir_out) {
    const int tid = tid_fresh(), lane = tid & 63, wave = tid >> 6;
    const int gw = blockIdx.x * 8 + wave, NGW = gridDim.x * 8;
    unsigned char* ws = p.ws;
    LAS f32x4* GWa = (LAS f32x4*)L; LAS f32x4* GWb = (LAS f32x4*)(L + 16384);
    if (GATES) {
        const float* win = p.in[11];
        for (int idx = tid; idx < 8192; idx += 512) { const int k = idx >> 3, g = idx & 7; const float val = win[(size_t)k * 2824 + 2048 + g];
            const int j = k >> 8, ln = (k & 255) >> 2, i = k & 3; const int kk = (j * 4 + i) * 64 + ln;
            ((LAS float*)L)[(g < 4 ? 0 : 4096) + kk * 4 + (g & 3)] = val; }
        __syncthreads();
    }
    f32x4 gp[4], gq[4];
#pragma unroll
    for (int j = 0; j < 4; ++j) { gp[j] = ((const f32x4*)(p.in[7] + gpost * DM))[64 * j + lane] * coef; gq[j] = LAST ? gp[j] : ((const f32x4*)(p.in[7] + gpre * DM))[64 * j + lane]; }
    const bf16* Y = (const bf16*)(ws + WS_Y); float* GA = (float*)(ws + WS_GATES);
    f32x4 xf[4], xfn[4]; v2u xh[4], xhn[4]; v2u yr[4], ynx[4];
#define RP_LOAD(R, XF, XH, YR) do { const int r_ = (R); \
        if (FIRST) { const float* xin = r_ < NP ? p.in[0] + (size_t)r_ * DM : p.in[1] + (size_t)(r_ - NP) * DM; _Pragma("unroll") for (int j = 0; j < 4; ++j) XF[j] = ((const f32x4*)xin)[64 * j + lane]; } \
        else { _Pragma("unroll") for (int j = 0; j < 4; ++j) XH[j] = ((const v2u*)(xb_in + (size_t)r_ * DM))[64 * j + lane]; } \
        _Pragma("unroll") for (int j = 0; j < 4; ++j) YR[j] = ((const v2u*)(Y + (size_t)r_ * DM))[64 * j + lane]; } while (0)
    RP_LOAD(gw < NROWS ? gw : 0, xf, xh, yr);
    float irc = FIRST ? 1.f : ir_in[gw < NROWS ? gw : 0];
    for (int r = gw; r < NROWS; r += NGW) {
        RP_LOAD((r + NGW) < NROWS ? (r + NGW) : r, xfn, xhn, ynx);
        const float irn = FIRST ? 1.f : ir_in[(r + NGW) < NROWS ? (r + NGW) : r];
        f32x4 xv[4], yv[4]; float ss = 0.f;
#pragma unroll
        for (int j = 0; j < 4; ++j) { const v2u yy = yr[j];
            xv[j] = FIRST ? xf[j] : (f32x4){bflo(xh[j].x), bfhi(xh[j].x), bflo(xh[j].y), bfhi(xh[j].y)} * irc;
            yv[j] = (f32x4){bflo(yy.x), bfhi(yy.x), bflo(yy.y), bfhi(yy.y)}; ss += (yv[j][0] * yv[j][0] + yv[j][1] * yv[j][1]) + (yv[j][2] * yv[j][2] + yv[j][3] * yv[j][3]); }
        const float r1 = rsqrtf(wave_sum(ss) * (1.f / DM) + EPS);
        float s2 = 0.f;
#pragma unroll
        for (int j = 0; j < 4; ++j) { xv[j] = xv[j] + yv[j] * r1 * gp[j];
            if (LAST) __builtin_nontemporal_store(xv[j], &((f32x4*)(p.out + (size_t)r * DM))[64 * j + lane]);
            s2 += (xv[j][0] * xv[j][0] + xv[j][1] * xv[j][1]) + (xv[j][2] * xv[j][2] + xv[j][3] * xv[j][3]); }
        if (!LAST) {
            const float m2 = wave_sum(s2) * (1.f / DM) + EPS; const float r2 = rsqrtf(m2);
            v2u* o = (v2u*)(xb_out + (size_t)r * DM);
#pragma unroll
            for (int j = 0; j < 4; ++j) { xv[j] = xv[j] * r2; v2u w; w.x = pk2(xv[j][0], xv[j][1]); w.y = pk2(xv[j][2], xv[j][3]); o[64 * j + lane] = w; }
            if (lane == 0) ir_out[r] = sqrtf(m2);
            if (GATES) {
#pragma unroll
                for (int j = 0; j < 4; ++j) xv[j] = xv[j] * gq[j];
                f32x4 ga = {0.f, 0.f, 0.f, 0.f}, gb = {0.f, 0.f, 0.f, 0.f};
#pragma unroll
                for (int j = 0; j < 4; ++j)
#pragma unroll
                    for (int i = 0; i < 4; ++i) { const int kk = (j * 4 + i) * 64 + lane; ga += GWa[kk] * xv[j][i]; gb += GWb[kk] * xv[j][i]; }
#pragma unroll
                for (int i = 0; i < 4; ++i) { ga[i] = wave_sum(ga[i]); gb[i] = wave_sum(gb[i]); }
                if (lane == 0) { const f32x4 b0 = ((const f32x4*)p.in[12])[0], b1 = ((const f32x4*)p.in[12])[1]; ((f32x4*)(GA + (size_t)r * 8))[0] = ga + b0; ((f32x4*)(GA + (size_t)r * 8))[1] = gb + b1; }
            }
        }
#pragma unroll
        for (int j = 0; j < 4; ++j) { if (FIRST) xf[j] = xfn[j]; else xh[j] = xhn[j]; yr[j] = ynx[j]; }
        irc = irn;
    }
#undef RP_LOAD
    if (GATES) __syncthreads();
}

__device__ __forceinline__ void stats_item(const Params& p, LAS unsigned char* L, int bh) {
    const int tid = tid_fresh(), lane = tid & 63, wave = tid >> 6; const int b = bh >> 2, h = bh & 3;
    LAS float* sBL = (LAS float*)L; LAS float* sGM = (LAS float*)(L + 512);
    const float* GA = (const float*)(p.ws + WS_GATES);
    float igv[16], fgv[16];
#pragma unroll
    for (int ci = 0; ci < 16; ++ci) { const int ch = wave + 8 * ci; const size_t row = (size_t)b * 8192 + ch * 64 + lane; igv[ci] = GA[row * 8 + h]; fgv[ci] = GA[row * 8 + 4 + h]; }
#pragma unroll
    for (int ci = 0; ci < 16; ++ci) { const int ch = wave + 8 * ci;
        const float bc = scan_sum(logsig(fgv[ci]), lane); const float bL = RDL_F(bc, 63); const float gm = wave_max(bL - bc + igv[ci]);
        if (lane == 0) { sBL[ch] = bL; sGM[ch] = gm; } }
    __syncthreads();
    if (wave == 0) {
        const float a0 = sBL[2 * lane], b0 = sGM[2 * lane], a1 = sBL[2 * lane + 1], b1 = sGM[2 * lane + 1];
        float A = a0 + a1, B = fmaxf(b0 + a1, b1);
#pragma unroll
        for (int o = 1; o < 64; o <<= 1) { const float Ap = __shfl_up(A, o), Bp = __shfl_up(B, o); if (lane >= o) { B = fmaxf(Bp + A, B); A = Ap + A; } }
        float Ae = __shfl_up(A, 1), Be = __shfl_up(B, 1); if (lane == 0) { Ae = 0.f; Be = -INFINITY; }
        const float m_in0 = fmaxf(Ae, Be);
        const float m_in1 = fmaxf(m_in0 + a0, b0);
        const float m_out = fmaxf(m_in1 + a1, b1);
        float* MST = (float*)(p.ws + WS_MST) + bh * 132; float* DEC = (float*)(p.ws + WS_DEC) + bh * 128;
        MST[2 * lane] = lane == 0 ? 0.f : m_in0; MST[2 * lane + 1] = m_in1; if (lane == 63) { MST[128] = m_out; p.out[O_PM + bh] = m_out; }
        DEC[2 * lane] = __expf(a0 + (lane == 0 ? 0.f : m_in0) - m_in1); DEC[2 * lane + 1] = __expf(a1 + m_in1 - m_out);
    }
    __syncthreads();
}

__device__ __forceinline__ void mlstm_dcs_phase(const Params& p, LAS unsigned char* L) {
    const int tid = tid_fresh(), lane = tid & 63, wave = tid >> 6, r16 = lane & 15, quad = lane >> 4;
    LAS bf16* sK = (LAS bf16*)L; LAS bf16* sV = (LAS bf16*)(L + 18432); LAS float* sWK = (LAS float*)(L + 36864);
    const int trq = (lane & 15) >> 2, trp = lane & 3;
    const bf16* Z = (const bf16*)(p.ws + WS_HZ); const float* GA = (const float*)(p.ws + WS_GATES); const float* MST = (const float*)(p.ws + WS_MST); const float* DEC = (const float*)(p.ws + WS_DEC);
    v4u kq[2], vq[2]; float ig = 0.f, fg = 0.f, mn = 0.f;
#define DC_LOAD(IT) do { const int bh_ = (IT) >> 7, ch_ = (IT) & 127; const int row0_ = (bh_ >> 2) * 8192 + ch_ * 64, h_ = bh_ & 3; \
        _Pragma("unroll") for (int i = 0; i < 2; ++i) { const int pc = tid + 512 * i, t = pc >> 4, piece = pc & 15; const bf16* zr = Z + (size_t)(row0_ + t) * ZW + h_ * 128 + piece * 8; kq[i] = *(const v4u*)(zr + 512); vq[i] = *(const v4u*)(zr + 1024); } \
        if (wave == 0) { const size_t row = (size_t)row0_ + lane; ig = GA[row * 8 + h_]; fg = GA[row * 8 + 4 + h_]; mn = MST[bh_ * 132 + ch_ + 1]; } } while (0)
    for (int unit = blockIdx.x; unit < 256; unit += gridDim.x) {
        const int bh = unit >> 5, sc = unit & 31;
        f32x4 acc[8]; float nacc = 0.f;
#pragma unroll
        for (int mi = 0; mi < 8; ++mi) acc[mi] = (f32x4){0.f, 0.f, 0.f, 0.f};
        DC_LOAD(bh * 128 + 4 * sc);
        for (int j = 0; j < 4; ++j) {
            const int ch = 4 * sc + j;
            if (wave == 0) { const float bc = scan_sum(logsig(fg), lane); const float bL = RDL_F(bc, 63); sWK[lane] = __expf(bL - bc + ig - mn); }
            __syncthreads();
#pragma unroll
            for (int i = 0; i < 2; ++i) { const int pc = tid + 512 * i, t = pc >> 4, piece = pc & 15; const float wk = sWK[t]; v4u ks;
#pragma unroll
                for (int w = 0; w < 4; ++w) ks[w] = pk2(bflo(kq[i][w]) * wk, bfhi(kq[i][w]) * wk);
                *(LAS v4u*)(sK + t * 144 + piece * 8) = ks; *(LAS v4u*)(sV + t * 144 + piece * 8) = vq[i]; }
            __syncthreads();
            if (j < 3) DC_LOAD(bh * 128 + ch + 1);
            __builtin_amdgcn_sched_barrier(0);
            const float dec = DEC[bh * 128 + ch];
#pragma unroll
            for (int mi = 0; mi < 8; ++mi) acc[mi] = acc[mi] * dec;
#pragma unroll
            for (int kk = 0; kk < 2; ++kk) { const int rb = (32 * kk + 8 * quad + trq) * 144 + 4 * trp; const bf16x8 bfr = tr_frag(sV + rb + 16 * wave, sV + rb + 4 * 144 + 16 * wave);
#pragma unroll
                for (int mi = 0; mi < 8; ++mi) { const bf16x8 afr = tr_frag(sK + rb + 16 * mi, sK + rb + 4 * 144 + 16 * mi); acc[mi] = MFMA16(afr, bfr, acc[mi]); } }
            if (tid < 128) { float s = 0.f;
#pragma unroll 8
                for (int t = 0; t < 64; ++t) s += bf2f(sK[t * 144 + tid]);
                nacc = nacc * dec + s; }
            __syncthreads();
        }
        bf16* ct = (bf16*)(p.ws + WS_CT) + (((size_t)(bh * 128 + 16 * wave + r16) * 32 + sc) << 7);
#pragma unroll
        for (int mi = 0; mi < 8; ++mi) { v2u o; o.x = pk2_sw(acc[mi][0], acc[mi][1]); o.y = pk2_sw(acc[mi][2], acc[mi][3]); *(v2u*)(ct + 16 * mi + 4 * quad) = o; }
        if (tid < 128) ((float*)(p.ws + WS_NB))[(size_t)(bh * 32 + sc) * 128 + tid] = nacc;
    }
#undef DC_LOAD
}

__device__ __forceinline__ void swa_prompt_item(const Params& p, LAS unsigned char* L, int item) {
    const int tid = tid_fresh(), lane = tid & 63, wave = tid >> 6, r16 = lane & 15, quad = lane >> 4;
    const int b = item >> 7, nb = (item >> 1) & 63, kvh = item & 1;
    LAS bf16* sK = (LAS bf16*)L; LAS bf16* sVT = (LAS bf16*)(L + 36864);
    const bf16* Z = (const bf16*)(p.ws + WS_HZ); bf16* U = (bf16*)(p.ws + WS_XN);
#pragma unroll
    for (int i = 0; i < 4; ++i) { const int pc = tid + 512 * i, j = pc >> 3, piece = pc & 7; const int pos = nb * 128 - 128 + j;
        v4u kq = {0u, 0u, 0u, 0u}, vq = {0u, 0u, 0u, 0u};
        if (pos >= 0) { const bf16* zr = Z + (size_t)(b * 8192 + pos) * ZW + kvh * 64 + piece * 8; kq = *(const v4u*)(zr + 2560); vq = *(const v4u*)(zr + 2688); }
        *(LAS v4u*)(sK + j * 72 + piece * 8) = kq; *(LAS v4u*)(sVT + j * 72 + piece * 8) = vq;
        if (nb == 63 && j >= 128) { const size_t o = ((size_t)((b * 128 + (j - 128)) * 2 + kvh)) * 64 + piece * 8; float* ok = p.out + O_PSK + o; float* ov = p.out + O_PSV + o;
            ((f32x4*)ok)[0] = (f32x4){bflo(kq.x), bfhi(kq.x), bflo(kq.y), bfhi(kq.y)}; ((f32x4*)ok)[1] = (f32x4){bflo(kq.z), bfhi(kq.z), bflo(kq.w), bfhi(kq.w)};
            ((f32x4*)ov)[0] = (f32x4){bflo(vq.x), bfhi(vq.x), bflo(vq.y), bfhi(vq.y)}; ((f32x4*)ov)[1] = (f32x4){bflo(vq.z), bfhi(vq.z), bflo(vq.w), bfhi(vq.w)}; } }
    bf16x8 qn0, qn1;
    { const int rt = wave * 4, g = rt >> 3, qt = rt & 7, hh = kvh * 4 + g;
        const size_t qrow = (size_t)b * 8192 + nb * 128 + 16 * qt + r16; const bf16* qp = Z + qrow * ZW + 2048 + hh * 64 + 8 * quad; qn0 = *(const bf16x8*)qp; qn1 = *(const bf16x8*)(qp + 32); }
    __syncthreads();
#pragma nounroll
    for (int i = 0; i < 4; ++i) { const int rt = wave * 4 + i, g = rt >> 3, qt = rt & 7, hh = kvh * 4 + g; const int kt0 = qt < 6 ? qt : 6;
        const bf16x8 qf0 = qn0, qf1 = qn1;
        if (i < 3) { const int rt2 = rt + 1, g2 = rt2 >> 3, qt2 = rt2 & 7, hh2 = kvh * 4 + g2;
            const size_t qrow = (size_t)b * 8192 + nb * 128 + 16 * qt2 + r16; const bf16* qp = Z + qrow * ZW + 2048 + hh2 * 64 + 8 * quad; qn0 = *(const bf16x8*)qp; qn1 = *(const bf16x8*)(qp + 32); }
        f32x4 s[10];
#pragma unroll
        for (int kt = 0; kt < 10; ++kt) { const LAS bf16* kp = sK + (16 * (kt0 + kt) + r16) * 72 + 8 * quad; const bf16x8 k0 = *(const LAS bf16x8*)kp, k1 = *(const LAS bf16x8*)(kp + 32);
            s[kt] = MFMA16(k0, qf0, ((f32x4){0.f, 0.f, 0.f, 0.f})); s[kt] = MFMA16(k1, qf1, s[kt]); }
        const float slope = exp2f(-(float)(hh + 1)), sink = p.in[14][hh]; const int qi = 16 * qt + r16; float mx = sink;
        const float fd0 = (float)(128 + qi - 16 * kt0 - 4 * quad); const unsigned limb = __float_as_uint((float)(nb > 0 ? 128 : (qi + 1 < 128 ? qi + 1 : 128)));
#pragma unroll
        for (int kt = 0; kt < 10; ++kt)
#pragma unroll
            for (int rg = 0; rg < 4; ++rg) { const float fdist = fd0 - (float)(16 * kt + rg); const bool valid = __float_as_uint(fdist) < limb;
                const float v = valid ? s[kt][rg] - slope * fdist : -INFINITY; s[kt][rg] = v; mx = fmaxf(mx, v); }
        mx = fmaxf(mx, __shfl_xor(mx, 16)); mx = fmaxf(mx, __shfl_xor(mx, 32));
        float sum = 0.f;
#pragma unroll
        for (int kt = 0; kt < 10; ++kt)
#pragma unroll
            for (int rg = 0; rg < 4; ++rg) { const float e = __expf(s[kt][rg] - mx); s[kt][rg] = e; sum += e; }
        sum += __shfl_xor(sum, 16); sum += __shfl_xor(sum, 32);
        const float inv = __builtin_amdgcn_rcpf(sum + __expf(sink - mx));
        f32x4 o[4];
#pragma unroll
        for (int nd = 0; nd < 4; ++nd) o[nd] = (f32x4){0.f, 0.f, 0.f, 0.f};
#pragma unroll
        for (int i2 = 0; i2 < 5; ++i2) { const bf16x8 pa = pack8(s[2 * i2], s[2 * i2 + 1]);
#pragma unroll
            for (int nd = 0; nd < 4; ++nd) { const LAS bf16* vp = sVT + (16 * (kt0 + 2 * i2) + 4 * quad + ((lane & 15) >> 2)) * 72 + 16 * nd + 4 * (lane & 3);
                const bf16x8 vb = tr_frag(vp, vp + 16 * 72); o[nd] = MFMA16(pa, vb, o[nd]); } }
#pragma unroll
        for (int rg = 0; rg < 4; ++rg) { const float iv = __shfl(inv, 4 * quad + rg); const size_t orow = (size_t)b * 8192 + nb * 128 + 16 * qt + 4 * quad + rg;
#pragma unroll
            for (int nd = 0; nd < 4; ++nd) U[orow * DM + 512 + hh * 64 + 16 * nd + r16] = (bf16)f2bf(o[nd][rg] * iv); }
    }
    __syncthreads();
}

__device__ __forceinline__ void swa_sample_item(const Params& p, LAS unsigned char* L, int item) {
    const int tid = tid_fresh(), lane = tid & 63, wave = tid >> 6, r16 = lane & 15, quad = lane >> 4; const int bd = item >> 1, kvh = item & 1; const int row0 = NP + bd * 4;
    LAS bf16* sK = (LAS bf16*)L;
    LAS bf16* sV = (LAS bf16*)(L + 23040);
    const bf16* Z = (const bf16*)(p.ws + WS_HZ); bf16* U = (bf16*)(p.ws + WS_XN);
#pragma unroll
    for (int i = 0; i < 3; ++i) { const int pc = tid + 512 * i; if (pc < 1280) { const int j = pc >> 3, piece = pc & 7; v4u kq = {0u, 0u, 0u, 0u}, vq = {0u, 0u, 0u, 0u};
            if (j < 128) { const size_t o = ((size_t)((bd * 128 + j) * 2 + kvh)) * 64 + piece * 8;
                const f32x4 k0 = __builtin_nontemporal_load((const f32x4*)(p.in[2] + o)), k1 = __builtin_nontemporal_load((const f32x4*)(p.in[2] + o + 4)), v0 = __builtin_nontemporal_load((const f32x4*)(p.in[3] + o)), v1 = __builtin_nontemporal_load((const f32x4*)(p.in[3] + o + 4));
                kq.x = pk2(k0[0], k0[1]); kq.y = pk2(k0[2], k0[3]); kq.z = pk2(k1[0], k1[1]); kq.w = pk2(k1[2], k1[3]);
                vq.x = pk2(v0[0], v0[1]); vq.y = pk2(v0[2], v0[3]); vq.z = pk2(v1[0], v1[1]); vq.w = pk2(v1[2], v1[3]);
                if (j >= 4) { const size_t oo = o - 4 * 128; __builtin_nontemporal_store(k0, (f32x4*)(p.out + O_SSK + oo)); __builtin_nontemporal_store(k1, (f32x4*)(p.out + O_SSK + oo + 4)); __builtin_nontemporal_store(v0, (f32x4*)(p.out + O_SSV + oo)); __builtin_nontemporal_store(v1, (f32x4*)(p.out + O_SSV + oo + 4)); } }
            else if (j < 132) { const bf16* zr = Z + (size_t)(row0 + j - 128) * ZW + kvh * 64 + piece * 8; kq = *(const v4u*)(zr + 2560); vq = *(const v4u*)(zr + 2688);
                const size_t oo = ((size_t)((bd * 128 + (j - 4)) * 2 + kvh)) * 64 + piece * 8;
                *(f32x4*)(p.out + O_SSK + oo) = (f32x4){bflo(kq.x), bfhi(kq.x), bflo(kq.y), bfhi(kq.y)}; *(f32x4*)(p.out + O_SSK + oo + 4) = (f32x4){bflo(kq.z), bfhi(kq.z), bflo(kq.w), bfhi(kq.w)};
                *(f32x4*)(p.out + O_SSV + oo) = (f32x4){bflo(vq.x), bfhi(vq.x), bflo(vq.y), bfhi(vq.y)}; *(f32x4*)(p.out + O_SSV + oo + 4) = (f32x4){bflo(vq.z), bfhi(vq.z), bflo(vq.w), bfhi(vq.w)}; }
            *(LAS v4u*)(sK + j * 72 + piece * 8) = kq; *(LAS v4u*)(sV + j * 72 + piece * 8) = vq; } }
    __syncthreads();
    if (wave == 0) {
        const int sq = r16 >> 2, g = r16 & 3, hh = kvh * 4 + g; const bf16* qp = Z + (size_t)(row0 + sq) * ZW + 2048 + hh * 64 + 8 * quad;
        const bf16x8 qf0 = *(const bf16x8*)qp, qf1 = *(const bf16x8*)(qp + 32);
        f32x4 s[10];
#pragma unroll
        for (int kt = 0; kt < 10; ++kt) { const LAS bf16* kp = sK + (16 * kt + r16) * 72 + 8 * quad; const bf16x8 k0 = *(const LAS bf16x8*)kp, k1 = *(const LAS bf16x8*)(kp + 32);
            s[kt] = MFMA16(k0, qf0, ((f32x4){0.f, 0.f, 0.f, 0.f})); s[kt] = MFMA16(k1, qf1, s[kt]); }
        const float slope = exp2f(-(float)(hh + 1)), sink = p.in[14][hh]; float mx = sink;
#pragma unroll
        for (int kt = 0; kt < 10; ++kt)
#pragma unroll
            for (int rg = 0; rg < 4; ++rg) { const int j = 16 * kt + 4 * quad + rg; const int dist = 128 + sq - j; const bool valid = dist >= 0 && dist < 128;
                const float v = valid ? s[kt][rg] - slope * (float)dist : -INFINITY; s[kt][rg] = v; mx = fmaxf(mx, v); }
        mx = fmaxf(mx, __shfl_xor(mx, 16)); mx = fmaxf(mx, __shfl_xor(mx, 32));
        float sum = 0.f;
#pragma unroll
        for (int kt = 0; kt < 10; ++kt)
#pragma unroll
            for (int rg = 0; rg < 4; ++rg) { const float e = __expf(s[kt][rg] - mx); s[kt][rg] = e; sum += e; }
        sum += __shfl_xor(sum, 16); sum += __shfl_xor(sum, 32);
        const float inv = __builtin_amdgcn_rcpf(sum + __expf(sink - mx));
        f32x4 o[4];
#pragma unroll
        for (int nd = 0; nd < 4; ++nd) o[nd] = (f32x4){0.f, 0.f, 0.f, 0.f};
#pragma unroll
        for (int i2 = 0; i2 < 5; ++i2) { const bf16x8 pa = pack8(s[2 * i2], s[2 * i2 + 1]);
#pragma unroll
            for (int nd = 0; nd < 4; ++nd) { const LAS bf16* vp = sV + (32 * i2 + 4 * quad + ((lane & 15) >> 2)) * 72 + 16 * nd + 4 * (lane & 3);
                const bf16x8 vb = tr_frag(vp, vp + 16 * 72); o[nd] = MFMA16(pa, vb, o[nd]); } }
#pragma unroll
        for (int rg = 0; rg < 4; ++rg) { const int rq = 4 * quad + rg; const float iv = __shfl(inv, rq); const int so = rq >> 2, go = rq & 3;
#pragma unroll
            for (int nd = 0; nd < 4; ++nd) U[(size_t)(row0 + so) * DM + 512 + (kvh * 4 + go) * 64 + 16 * nd + r16] = (bf16)f2bf(o[nd][rg] * iv); }
    }
    __syncthreads();
}

__device__ __forceinline__ void mlstm_sample_item(const Params& p, LAS unsigned char* L, int item) {
    const int tid = tid_fresh(), lane = tid & 63, wave = tid >> 6; const int bd = item >> 2, h = item & 3; const int row0 = NP + bd * 4;
    LAS float* sq = (LAS float*)L;
    LAS float* sk = sq + 512; LAS float* sv = sq + 1024; LAS float* sn = sq + 1536;
    LAS float* sQK = sq + 1664;
    LAS float* sQN = sq + 1680;
    LAS float* sSS = sq + 1688;
    LAS float* sPart = sq + 1792;
    const bf16* Z = (const bf16*)(p.ws + WS_HZ); bf16* U = (bf16*)(p.ws + WS_XN); const float* GA = (const float*)(p.ws + WS_GATES);
    float cin[32]; { const int v = tid & 127, ks = tid >> 7; const float* Cin = p.in[4] + ((size_t)(bd * 4 + h) << 14);
#pragma unroll
        for (int kk = 0; kk < 32; ++kk) cin[kk] = __builtin_nontemporal_load(&Cin[(ks * 32 + kk) * 128 + v]); }
    const float og_pre = bf2f(Z[(size_t)(row0 + (tid >> 7)) * ZW + 1536 + h * 128 + (tid & 127)]);
    for (int idx = tid; idx < 1536; idx += 512) { const int w = idx >> 9, r = idx & 511, t = r >> 7, d = r & 127; sq[idx] = bf2f(Z[(size_t)(row0 + t) * ZW + w * 512 + h * 128 + d]); }
    if (tid < 128) sn[tid] = p.in[5][(size_t)(bd * 4 + h) * 128 + tid];
    float ig[4], bc[4]; { float a = 0.f;
#pragma unroll
        for (int s = 0; s < 4; ++s) { ig[s] = GA[(size_t)(row0 + s) * 8 + h]; a += logsig(GA[(size_t)(row0 + s) * 8 + 4 + h]); bc[s] = a; } }
    const float m0 = p.in[6][bd * 4 + h];
    float mt[4], at[4], W[4][4];
#pragma unroll
    for (int t = 0; t < 4; ++t) { float md = -INFINITY;
#pragma unroll
        for (int s = 0; s <= t; ++s) md = fmaxf(md, bc[t] - bc[s] + ig[s]);
        mt[t] = fmaxf(bc[t] + m0, md); at[t] = __expf(bc[t] + m0 - mt[t]);
#pragma unroll
        for (int s = 0; s < 4; ++s) W[t][s] = s <= t ? __expf(bc[t] - bc[s] + ig[s] - mt[t]) : 0.f; }
    const float bL = bc[3]; float mnew = bL + m0; float wk[4];
#pragma unroll
    for (int s = 0; s < 4; ++s) mnew = fmaxf(mnew, bL - bc[s] + ig[s]);
    const float decay = __expf(bL + m0 - mnew);
#pragma unroll
    for (int s = 0; s < 4; ++s) wk[s] = __expf(bL - bc[s] + ig[s] - mnew);
    __syncthreads();
#pragma unroll
    for (int i = 0; i < 2; ++i) { const int pr = wave * 2 + i, t = pr >> 2, s = pr & 3; const float a = wave_sum(sq[t * 128 + lane] * sk[s * 128 + lane] + sq[t * 128 + 64 + lane] * sk[s * 128 + 64 + lane]); if (lane == 0) sQK[pr] = a; }
    if (wave < 4) { const float a = wave_sum(sq[wave * 128 + lane] * sn[lane] + sq[wave * 128 + 64 + lane] * sn[64 + lane]); if (lane == 0) sQN[wave] = a; }
    { const int v = tid & 127, ks = tid >> 7; const float* Cin = p.in[4] + ((size_t)(bd * 4 + h) << 14); float* Cout = p.out + O_SC + ((size_t)(bd * 4 + h) << 14);
        const float v0 = sv[v], v1 = sv[128 + v], v2 = sv[256 + v], v3 = sv[384 + v];
        float a0 = 0.f, a1 = 0.f, a2 = 0.f, a3 = 0.f;
#pragma unroll
        for (int kk = 0; kk < 32; ++kk) { const int k = ks * 32 + kk; const float c = cin[kk];
            a0 += sq[k] * c; a1 += sq[128 + k] * c; a2 += sq[256 + k] * c; a3 += sq[384 + k] * c;
            __builtin_nontemporal_store(decay * c + (wk[0] * sk[k] * v0 + wk[1] * sk[128 + k] * v1) + (wk[2] * sk[256 + k] * v2 + wk[3] * sk[384 + k] * v3), &Cout[k * 128 + v]); }
        sPart[(ks * 4 + 0) * 128 + v] = a0; sPart[(ks * 4 + 1) * 128 + v] = a1; sPart[(ks * 4 + 2) * 128 + v] = a2; sPart[(ks * 4 + 3) * 128 + v] = a3; }
    if (tid < 128) p.out[O_SN + (size_t)(bd * 4 + h) * 128 + tid] = decay * sn[tid] + (wk[0] * sk[tid] + wk[1] * sk[128 + tid]) + (wk[2] * sk[256 + tid] + wk[3] * sk[384 + tid]);
    if (tid == 0) p.out[O_SM + bd * 4 + h] = mnew;
    __syncthreads();
    { const int t = tid >> 7, v = tid & 127; const float qc = (sPart[(0 * 4 + t) * 128 + v] + sPart[(1 * 4 + t) * 128 + v]) + (sPart[(2 * 4 + t) * 128 + v] + sPart[(3 * 4 + t) * 128 + v]);
        float att = 0.f, mtt = 0.f, num, den; float S[4];
#pragma unroll
        for (int tt = 0; tt < 4; ++tt) if (tt == t) { att = at[tt]; mtt = mt[tt];
#pragma unroll
            for (int s = 0; s < 4; ++s) S[s] = sQK[tt * 4 + s] * W[tt][s]; }
        num = att * qc + (S[0] * sv[v] + S[1] * sv[128 + v]) + (S[2] * sv[256 + v] + S[3] * sv[384 + v]);
        den = att * sQN[t] + (S[0] + S[1]) + (S[2] + S[3]);
        const float hv = num * __builtin_amdgcn_rcpf(fmaxf(fabsf(den), __expf(-mtt)));
        const float q2 = wave_sum(hv * hv); if (lane == 0) sSS[wave] = q2;
        __syncthreads();
        const float ss = sSS[2 * t] + sSS[2 * t + 1]; const float rn = rsqrtf(ss * (1.f / 128.f) + EPS);
        const float og = og_pre; const float sg = __builtin_amdgcn_rcpf(1.0f + __expf(-og));
        U[(size_t)(row0 + t) * DM + h * 128 + v] = (bf16)f2bf(hv * rn * p.in[13][h * 128 + v] * sg); }
    __syncthreads();
}

__device__ __forceinline__ void scan_phase(const Params& p, LAS unsigned char* L) {
    const int tid = tid_fresh(), lane = tid & 63, wave = tid >> 6;
    if (tid < 256) {
        for (int gid = blockIdx.x * 256 + tid; gid < 65536; gid += gridDim.x * 256) {
            const int bh = gid >> 13, dv = (gid & 8191) >> 6, dk = (gid & 63) * 2; unsigned* q = (unsigned*)((bf16*)(p.ws + WS_CT) + ((size_t)(bh * 128 + dv) << 12) + dk); const f32x4* dec4 = (const f32x4*)((const float*)(p.ws + WS_DEC) + bh * 128);
            float C0 = 0.f, C1 = 0.f; unsigned d[32]; float dc[32];
#pragma unroll
            for (int u = 0; u < 32; ++u) { d[u] = q[u * 64]; const f32x4 t = dec4[u]; dc[u] = (t[0] * t[1]) * (t[2] * t[3]); }
#pragma unroll
            for (int u = 0; u < 32; ++u) { q[u * 64] = pk2(C0, C1); C0 = dc[u] * C0 + bflo(d[u]); C1 = dc[u] * C1 + bfhi(d[u]); }
            float* pc = p.out + O_PC + ((size_t)bh << 14); pc[dk * 128 + dv] = C0; pc[(dk + 1) * 128 + dv] = C1; }
    } else if (wave == 4) {
        for (int idx = blockIdx.x * 64 + lane; idx < 1024; idx += gridDim.x * 64) { const int bh = idx >> 7, dk = idx & 127; float* q = (float*)(p.ws + WS_NB) + ((size_t)(bh * 32) << 7) + dk; const f32x4* dec4 = (const f32x4*)((const float*)(p.ws + WS_DEC) + bh * 128);
            float n = 0.f; float d[32], dc[32];
#pragma unroll
            for (int u = 0; u < 32; ++u) { d[u] = q[u * 128]; const f32x4 t = dec4[u]; dc[u] = (t[0] * t[1]) * (t[2] * t[3]); }
#pragma unroll
            for (int u = 0; u < 32; ++u) { q[u * 128] = n; n = dc[u] * n + d[u]; }
            p.out[O_PN + idx] = n; }
    }
    { LAS float* scr = (LAS float*)(L + wave * 16384);
        if (wave >= 5) { for (int it = blockIdx.x * 3 + (wave - 5); it < 1536; it += gridDim.x * 3) { if (it < 1408) conv_item(p, scr, lane, 4, it); else conv_item(p, scr, lane, 5, it - 1408); } }
        else { for (int it = 1536 + blockIdx.x * 5 + wave; it < 2816; it += gridDim.x * 5) conv_item(p, scr, lane, 5, it - 1408); } }
}

__device__ __forceinline__ void mlstm_out_phase(const Params& p, LAS unsigned char* L) {
    const int tid = tid_fresh(), lane = tid & 63, wave = tid >> 6, r16 = lane & 15, quad = lane >> 4;
    LAS bf16* sQ = (LAS bf16*)L; LAS bf16* sK = (LAS bf16*)(L + 17408); LAS bf16* sVT = (LAS bf16*)(L + 34816); LAS bf16* sCT = (LAS bf16*)(L + 53248);
    LAS float* sN = (LAS float*)(L + 88064); LAS float* sAl = sN + 128; LAS float* sBe = sAl + 64; LAS float* sA = sBe + 64; LAS float* sEm = sA + 64; LAS float* sQN = sEm + 64; LAS float* sSS = sQN + 64;
    LAS float* sWK = sSS + 128; LAS bf16* sVw = (LAS bf16*)(L + 90624);
    const bf16* Z = (const bf16*)(p.ws + WS_HZ); bf16* U = (bf16*)(p.ws + WS_XN);
    const int trq = (lane & 15) >> 2, trp = lane & 3;
    for (int unit = blockIdx.x; unit < 256; unit += gridDim.x) {
    const int bh = unit >> 5, sc = unit & 31, b = bh >> 2, h = bh & 3;
    { const bf16* ctg = (const bf16*)(p.ws + WS_CT) + ((size_t)(bh * 128) << 12) + ((size_t)sc << 7);
#pragma unroll
        for (int i = 0; i < 4; ++i) { const int pc = tid + 512 * i, dv = pc >> 4, piece = pc & 15; *(LAS v4u*)(sCT + dv * 136 + piece * 8) = *(const v4u*)(ctg + ((size_t)dv << 12) + piece * 8); } }
    if (tid < 128) sN[tid] = ((const float*)(p.ws + WS_NB))[(size_t)(bh * 32 + sc) * 128 + tid];
    __syncthreads();
    f32x4 cst[8];
#pragma unroll
    for (int mi = 0; mi < 8; ++mi) { const v2u w = *(const LAS v2u*)(sCT + (16 * wave + r16) * 136 + 16 * mi + 4 * quad); cst[mi] = (f32x4){bflo(w.x), bfhi(w.x), bflo(w.y), bfhi(w.y)}; }
    v4u nq[2], nk[2], nv[2]; float nig = 0.f, nfg = 0.f;
#define OUT_LOAD(CH) do { const int row0_ = b * 8192 + (CH) * 64; \
        _Pragma("unroll") for (int i = 0; i < 2; ++i) { const int pc = tid + 512 * i, t = pc >> 4, piece = pc & 15; const bf16* zr = Z + (size_t)(row0_ + t) * ZW + h * 128 + piece * 8; nq[i] = *(const v4u*)zr; nk[i] = *(const v4u*)(zr + 512); nv[i] = *(const v4u*)(zr + 1024); } \
        if (wave == 0) { const size_t row = (size_t)row0_ + lane; nig = ((const float*)(p.ws + WS_GATES))[row * 8 + h]; nfg = ((const float*)(p.ws + WS_GATES))[row * 8 + 4 + h]; } } while (0)
    OUT_LOAD(4 * sc);
    for (int j = 0; j < 4; ++j) {
    const int ch = 4 * sc + j; const int row0 = b * 8192 + ch * 64;
    if (wave == 0) { const float ig = nig, fg = nfg; const float bc = scan_sum(logsig(fg), lane); const float be = ig - bc; const float pm = scan_max(be, lane);
        const float mc = ((const float*)(p.ws + WS_MST))[bh * 132 + ch]; const float mt = bc + fmaxf(mc, pm);
        sAl[lane] = bc - mt; sBe[lane] = be; sA[lane] = __expf(bc + mc - mt); sEm[lane] = __expf(-mt);
        const float bL = RDL_F(bc, 63); sWK[lane] = __expf(bL + be - ((const float*)(p.ws + WS_MST))[bh * 132 + ch + 1]); }
#pragma unroll
    for (int i = 0; i < 2; ++i) { const int pc = tid + 512 * i, t = pc >> 4, piece = pc & 15;
        *(LAS v4u*)(sQ + t * 136 + piece * 8) = nq[i]; *(LAS v4u*)(sK + t * 136 + piece * 8) = nk[i];
        *(LAS v4u*)(sVT + t * 144 + piece * 8) = nv[i]; }
    __syncthreads();
    if (j < 3) OUT_LOAD(ch + 1);
    __builtin_amdgcn_sched_barrier(0);
    if (j < 3) {
#pragma unroll
        for (int i = 0; i < 2; ++i) { const int pc = tid + 512 * i, t = pc >> 4, piece = pc & 15; const float wk = sWK[t]; const v4u v4 = *(const LAS v4u*)(sVT + t * 144 + piece * 8); v4u o;
#pragma unroll
            for (int w = 0; w < 4; ++w) o[w] = pk2(bflo(v4[w]) * wk, bfhi(v4[w]) * wk);
            *(LAS v4u*)(sVw + t * 144 + piece * 8) = o; } }
    { const int t = tid >> 3, part = tid & 7; float s = 0.f;
#pragma unroll
        for (int e = 0; e < 16; ++e) s += bf2f(sQ[t * 136 + part * 16 + e]) * sN[part * 16 + e];
        s = row8_sum(s); if (part == 0) sQN[t] = s; }
    __syncthreads();
    const int tt = wave & 3, dh = wave >> 2;
    unsigned short ogr[4][4];
#pragma unroll
    for (int rg = 0; rg < 4; ++rg)
#pragma unroll
        for (int nv = 0; nv < 4; ++nv) ogr[rg][nv] = Z[(size_t)(row0 + 16 * tt + 4 * quad + rg) * ZW + 1536 + h * 128 + 16 * (4 * dh + nv) + r16];
    bf16x8 qf[4];
#pragma unroll
    for (int kk = 0; kk < 4; ++kk) qf[kk] = *(const LAS bf16x8*)(sQ + (16 * tt + r16) * 136 + 8 * quad + 32 * kk);
    f32x4 sT[4];
#pragma unroll
    for (int mi = 0; mi < 4; ++mi) { sT[mi] = (f32x4){0.f, 0.f, 0.f, 0.f};
#pragma unroll
        for (int kk = 0; kk < 4; ++kk) { const bf16x8 kf = *(const LAS bf16x8*)(sK + (16 * mi + r16) * 136 + 8 * quad + 32 * kk); sT[mi] = MFMA16(kf, qf[kk], sT[mi]); } }
    const int tl = 16 * tt + r16; const float al = sAl[tl]; float rs = 0.f;
#pragma unroll
    for (int mi = 0; mi < 4; ++mi)
#pragma unroll
        for (int rg = 0; rg < 4; ++rg) { const int si = 16 * mi + 4 * quad + rg; const float w = si <= tl ? __expf(al + sBe[si]) : 0.f; const float v = sT[mi][rg] * w; sT[mi][rg] = v; rs += v; }
    rs += __shfl_xor(rs, 16); rs += __shfl_xor(rs, 32);
    const float den = sA[tl] * sQN[tl] + rs; const float inv = __builtin_amdgcn_rcpf(fmaxf(fabsf(den), sEm[tl]));
    bf16x8 pa[2]; pa[0] = pack8(sT[0], sT[1]); pa[1] = pack8(sT[2], sT[3]);
    f32x4 acc[4];
#pragma unroll
    for (int nv = 0; nv < 4; ++nv) { acc[nv] = (f32x4){0.f, 0.f, 0.f, 0.f}; const int dvb = 16 * (4 * dh + nv) + r16;
#pragma unroll
        for (int kk = 0; kk < 4; ++kk) { const bf16x8 cf = *(const LAS bf16x8*)(sCT + dvb * 136 + 8 * quad + 32 * kk); acc[nv] = MFMA16(qf[kk], cf, acc[nv]); } }
#pragma unroll
    for (int rg = 0; rg < 4; ++rg) { const float ar = sA[16 * tt + 4 * quad + rg];
#pragma unroll
        for (int nv = 0; nv < 4; ++nv) acc[nv][rg] *= ar; }
#pragma unroll
    for (int i2 = 0; i2 < 2; ++i2)
#pragma unroll
        for (int nv = 0; nv < 4; ++nv) { const LAS bf16* vp = sVT + (32 * i2 + 4 * quad + ((lane & 15) >> 2)) * 144 + 16 * (4 * dh + nv) + 4 * (lane & 3);
            const bf16x8 vb = tr_frag(vp, vp + 16 * 144); acc[nv] = MFMA16(pa[i2], vb, acc[nv]); }
#pragma unroll
    for (int rg = 0; rg < 4; ++rg) { const float iv = __shfl(inv, 4 * quad + rg); float q2 = 0.f;
#pragma unroll
        for (int nv = 0; nv < 4; ++nv) { acc[nv][rg] *= iv; q2 += acc[nv][rg] * acc[nv][rg]; }
        q2 = row16_sum(q2);
        if (r16 == 0) sSS[dh * 64 + 16 * tt + 4 * quad + rg] = q2; }
    __syncthreads();
    if (j < 3) {
        const float dec = ((const float*)(p.ws + WS_DEC))[bh * 128 + ch];
#pragma unroll
        for (int mi = 0; mi < 8; ++mi) cst[mi] = cst[mi] * dec;
#pragma unroll
        for (int kk = 0; kk < 2; ++kk) { const int rw = 32 * kk + 8 * quad + trq; const bf16x8 bfr = tr_frag(sVw + rw * 144 + 4 * trp + 16 * wave, sVw + (rw + 4) * 144 + 4 * trp + 16 * wave);
#pragma unroll
            for (int mi = 0; mi < 8; ++mi) { const bf16x8 afr = tr_frag(sK + rw * 136 + 4 * trp + 16 * mi, sK + (rw + 4) * 136 + 4 * trp + 16 * mi); cst[mi] = MFMA16(afr, bfr, cst[mi]); } }
#pragma unroll
        for (int mi = 0; mi < 8; ++mi) { v2u o; o.x = pk2_sw(cst[mi][0], cst[mi][1]); o.y = pk2_sw(cst[mi][2], cst[mi][3]); *(LAS v2u*)(sCT + (16 * wave + r16) * 136 + 16 * mi + 4 * quad) = o; }
        if (tid < 128) { float s = 0.f;
#pragma unroll 8
            for (int t = 0; t < 64; ++t) s += bf2f(sK[t * 136 + tid]) * sWK[t];
            sN[tid] = dec * sN[tid] + s; } }
#pragma unroll
    for (int rg = 0; rg < 4; ++rg) { const int to = 16 * tt + 4 * quad + rg; const float rn = rsqrtf((sSS[to] + sSS[64 + to]) * (1.f / 128.f) + EPS);
#pragma unroll
        for (int nv = 0; nv < 4; ++nv) { const int dv = 16 * (4 * dh + nv) + r16; const float og = bf2f(ogr[rg][nv]); const float sg = __builtin_amdgcn_rcpf(1.0f + __expf(-og));
            U[(size_t)(row0 + to) * DM + h * 128 + dv] = (bf16)f2bf(acc[nv][rg] * rn * p.in[13][h * 128 + dv] * sg); } }
    __syncthreads();
    }
#undef OUT_LOAD
    }
}

template <int K>
__device__ __forceinline__ void sample_gemm_piece(LAS unsigned char* L, const bf16* A, const bf16* Bt, bf16* Yo, int piece) {
    const int tid = tid_fresh(), lane = tid & 63, wave = tid >> 6, r16 = lane & 15, quad = lane >> 4;
    const int mrow0 = (piece >> 4) * 32, ncol0 = (piece & 15) * 64; constexpr int KW = K / 8, NK = KW / 32;
    f32x4 acc[2][4];
#pragma unroll
    for (int mi = 0; mi < 2; ++mi)
#pragma unroll
        for (int ni = 0; ni < 4; ++ni) acc[mi][ni] = (f32x4){0.f, 0.f, 0.f, 0.f};
    const bf16* ap = A + (size_t)(mrow0 + r16) * K + wave * KW + 8 * quad; const bf16* bp = Bt + (size_t)(ncol0 + r16) * K + wave * KW + 8 * quad;
#pragma unroll
    for (int ks = 0; ks < NK; ++ks) { bf16x8 a[2], b[4];
#pragma unroll
        for (int mi = 0; mi < 2; ++mi) a[mi] = *(const bf16x8*)(ap + (size_t)(16 * mi) * K + 32 * ks);
#pragma unroll
        for (int ni = 0; ni < 4; ++ni) b[ni] = *(const bf16x8*)(bp + (size_t)(16 * ni) * K + 32 * ks);
#pragma unroll
        for (int mi = 0; mi < 2; ++mi)
#pragma unroll
            for (int ni = 0; ni < 4; ++ni) acc[mi][ni] = MFMA16(a[mi], b[ni], acc[mi][ni]); }
    LAS float* red = (LAS float*)L + wave * 2048;
#pragma unroll
    for (int mi = 0; mi < 2; ++mi)
#pragma unroll
        for (int ni = 0; ni < 4; ++ni)
#pragma unroll
            for (int rg = 0; rg < 4; ++rg) red[(16 * mi + 4 * quad + rg) * 64 + 16 * ni + r16] = acc[mi][ni][rg];
    __syncthreads();
    { const int row = tid >> 4, c4 = (tid & 15) * 4; f32x4 s = {0.f, 0.f, 0.f, 0.f};
#pragma unroll
        for (int w = 0; w < 8; ++w) s += *(const LAS f32x4*)((LAS float*)L + w * 2048 + row * 64 + c4);
        v2u o; o.x = pk2(s[0], s[1]); o.y = pk2(s[2], s[3]); *(v2u*)(Yo + (size_t)(mrow0 + row) * DM + ncol0 + c4) = o; }
    __syncthreads();
}

template <class Epi>
__device__ __forceinline__ void run_gemm(LAS unsigned char* L, const bf16* A, const bf16* Bt, int M, int N, int K, const Epi& E) {
    pg8::Gemm g{A, Bt, M, N, K}; pg8::StaticOrder S; S.init(M, N, (int)gridDim.x, (int)blockIdx.x);
    pg8::gemm_phase<Epi, pg8::StaticOrder, true, true>((PG8_LAS unsigned char*)L, g, S, E);
}

__global__ void __launch_bounds__(512, 2) fwd_megakernel(Params p) {
    extern __shared__ __attribute__((aligned(16))) unsigned char lds_raw[];
    LAS unsigned char* L = (LAS unsigned char*)lds_raw;
    cg::grid_group grid = cg::this_grid();
    unsigned char* ws = p.ws;
    bf16* XN = (bf16*)(ws + WS_XN); bf16* HZ = (bf16*)(ws + WS_HZ); bf16* Y = (bf16*)(ws + WS_Y);
    const int G = gridDim.x, bx = blockIdx.x;

    if (threadIdx.x < 8) ((LAS unsigned*)(L + 131072))[threadIdx.x] = 0u;
    __syncthreads();
    const XcdBarrier bar = xcd_barrier_post((unsigned*)(ws + WS_CTL), (volatile LAS unsigned*)(L + 131072));
    if (p.out == nullptr) grid.sync();
    prologue(p, L);
    xcd_barrier(bar);
    { pg8::EpiSwiglu E{HZ, DFF}; run_gemm(L, XN, (const bf16*)(ws + WS_WGU1), NROWS, 2 * DFF, DM, E); }
    { const int rem = 1452 % G; if (rem != 0 && bx >= rem) conv_tail_a(p, L, bx - rem, G - rem); else if (rem == 0) conv_tail_a(p, L, bx, G); }
    xcd_barrier(bar);
    { pg8::EpiBf16<0> E{Y, DM, nullptr, 0, 0, 1.f}; run_gemm(L, HZ, (const bf16*)(ws + WS_WD1), NP, DM, DFF, E); }
    for (int pc = bx; pc < 256; pc += G) sample_gemm_piece<DFF>(L, HZ + (size_t)NP * DFF, (const bf16*)(ws + WS_WD1), Y + (size_t)NP * DM, pc);
    xcd_barrier(bar);
    row_pass<false, false, true>(p, L, 0.5f, 1, 2, XN, (bf16*)p.out, (const float*)(ws + WS_RS) + 2 * NROWS, (float*)(ws + WS_RS));
    xcd_barrier(bar);
    { pg8::EpiBf16<0> E{HZ, ZW, nullptr, 0, 0, 1.f}; run_gemm(L, (const bf16*)p.out, (const bf16*)(ws + WS_WIN), NROWS, ZW, DM, E); }
    if (bx >= G - 8) stats_item(p, L, bx - (G - 8));
    xcd_barrier(bar);
    mlstm_dcs_phase(p, L);
    for (int it = bx; it < 256; it += G) swa_prompt_item(p, L, it);
    for (int it = bx; it < 512; it += G) mlstm_sample_item(p, L, it);
    for (int it = bx; it < 256; it += G) swa_sample_item(p, L, it);
    xcd_barrier(bar);
    scan_phase(p, L);
    xcd_barrier(bar);
    mlstm_out_phase(p, L);
    xcd_barrier(bar);
    { pg8::EpiBf16<0> E{Y, DM, nullptr, 0, 0, 1.f}; run_gemm(L, XN, (const bf16*)(ws + WS_WOUT), NP, DM, DM, E); }
    for (int pc = bx; pc < 256; pc += G) sample_gemm_piece<DM>(L, XN + (size_t)NP * DM, (const bf16*)(ws + WS_WOUT), Y + (size_t)NP * DM, pc);
    xcd_barrier(bar);
    row_pass<false, false, false>(p, L, 1.0f, 3, 4, (const bf16*)p.out, (bf16*)(ws + WS_CT), (const float*)(ws + WS_RS), (float*)(ws + WS_RS) + NROWS);
    xcd_barrier(bar);
    { pg8::EpiSwiglu E{HZ, DFF}; run_gemm(L, (const bf16*)(ws + WS_CT), (const bf16*)(ws + WS_WGU2), NROWS, 2 * DFF, DM, E); }
    xcd_barrier(bar);
    { pg8::EpiBf16<0> E{Y, DM, nullptr, 0, 0, 1.f}; run_gemm(L, HZ, (const bf16*)(ws + WS_WD2), NP, DM, DFF, E); }
    for (int pc = bx; pc < 256; pc += G) sample_gemm_piece<DFF>(L, HZ + (size_t)NP * DFF, (const bf16*)(ws + WS_WD2), Y + (size_t)NP * DM, pc);
    xcd_barrier(bar);
    row_pass<false, true, false>(p, L, 0.5f, 5, 5, (const bf16*)(ws + WS_CT), nullptr, (const float*)(ws + WS_RS) + NROWS, nullptr);
}

extern "C" void kernel_launch(void* const* d_in, const int* in_sizes, int n_in, void* d_out, int out_size, void* d_ws, size_t ws_size, hipStream_t stream) {
    static int grid = 0;
    if (grid == 0) {
        int dev = 0, cus = 0, per_cu = 0;
        hipGetDevice(&dev);
        hipDeviceGetAttribute(&cus, hipDeviceAttributeMultiprocessorCount, dev);
        hipFuncSetAttribute((const void*)fwd_megakernel, hipFuncAttributeMaxDynamicSharedMemorySize, LDS_BYTES);
        hipOccupancyMaxActiveBlocksPerMultiprocessor(&per_cu, (const void*)fwd_megakernel, 512, LDS_BYTES);
        if (per_cu < 1) { fprintf(stderr, "kernel_launch: occupancy query returned %d\n", per_cu); per_cu = 1; }
        (void)hipGetLastError();
        grid = cus * 1;
        if (n_in != 16 || ws_size < 240 * MiB) fprintf(stderr, "kernel_launch: unexpected n_in %d / ws %zu\n", n_in, ws_size);
    }
    Params p{};
    for (int i = 0; i < 16; ++i) p.in[i] = (const float*)d_in[i];
    p.out = (float*)d_out; p.ws = (unsigned char*)d_ws;
    (void)hipMemsetAsync((unsigned char*)d_ws + WS_CTL, 0, 16384, stream);
    void* args[] = {&p};
    hipError_t e = hipLaunchCooperativeKernel((const void*)fwd_megakernel, dim3(grid), dim3(512), args, LDS_BYTES, stream);
    if (e != hipSuccess) fprintf(stderr, "cooperative launch failed: %s (grid %d)\n", hipGetErrorString(e), grid);
}
```

```cpp
#include <hip/hip_runtime.h>
#include <hip/hip_cooperative_groups.h>
#include <cstdio>
#include <cstdint>
namespace cg = cooperative_groups;
__device__ __forceinline__ int tid_fresh() { int t = threadIdx.x; asm volatile("" : "+v"(t)); return t; }
namespace pg8 {
#define PG8_LAS __attribute__((address_space(3)))
typedef unsigned short bf16_t;
typedef short bf16x8 __attribute__((ext_vector_type(8)));
typedef float f32x4 __attribute__((ext_vector_type(4)));
typedef unsigned u32x4 __attribute__((ext_vector_type(4)));
constexpr int BM = 256, BK = 64, HALF = 128, HTB = HALF * BK * 2  , STAGE_BYTES = 8 * HTB, NXCD = 8, WGM = 8;

__host__ __device__ __forceinline__ int lds_byte(int r, int c) { const int st = (r >> 4) * 2 + (c >> 5), rr = r & 15, cc = c & 31, ob = rr * 64 + cc * 2; return st * 1024 + (ob ^ (((ob >> 9) & 1) << 5)); }
__host__ __device__ __forceinline__ void stage_rc(int b, int& R, int& C) { const int st = b / 1024, sb = b % 1024, swz = sb ^ (((sb >> 9) & 1) << 5); R = (st >> 1) * 16 + swz / 64; C = (st & 1) * 32 + (swz % 64) / 2; }
__host__ __device__ __forceinline__ int perm32(int rho) { const int n = rho >> 4, i = rho & 15; return 8 * (i >> 2) + 4 * n + (i & 3); }

struct Unit { int pm, pn; };
struct Gemm { const bf16_t* A; const bf16_t* Bt; int M, N, K; };

struct StaticOrder {
    int nM, nN, nwg, G, c;
    __host__ __device__ void init(int M, int N, int G_, int c_) { nM = M / BM; nN = N / BM; nwg = nM * nN; G = G_; c = c_; }
    __host__ __device__ bool next(int i, Unit& u) const {
        const long L = (long)i * G + c; if (L >= nwg) return false;
        int wgid = (int)L; { const int q = nwg / NXCD, r = nwg % NXCD, xcd = wgid % NXCD, off = wgid / NXCD; wgid = (xcd < r ? xcd * (q + 1) : r * (q + 1) + (xcd - r) * q) + off; }
        const int nig = WGM * nN, gid = wgid / nig, fm = gid * WGM, gsz = (nM - fm) < WGM ? (nM - fm) : WGM;
        u.pm = fm + ((wgid % nig) % gsz); u.pn = (wgid % nig) / gsz; return true;
    }
    __device__ __forceinline__ void a_ready(const Unit&) const {}
    __device__ __forceinline__ void done(const Unit&) const {}
};

__device__ __forceinline__ unsigned cvt_pk_bf16(float lo, float hi) { unsigned r; asm volatile("v_cvt_pk_bf16_f32 %0, %1, %2" : "=v"(r) : "v"(lo), "v"(hi)); return r; }
typedef float f32x2 __attribute__((ext_vector_type(2)));
__device__ __forceinline__ f32x2 gelu_pk(f32x2 v) {
    const f32x2 av = __builtin_elementwise_abs(v), d = av * 0.2316418882f + 1.0f;
    f32x2 t; t.x = __builtin_amdgcn_rcpf(d.x); t.y = __builtin_amdgcn_rcpf(d.y);
    f32x2 q = t * 0.5307027145f + (-0.7265760135f); q = q * t + 0.7107068705f; q = q * t + (-0.142248368f); q = q * t + 0.127414796f; q = q * t;
    const f32x2 s = (v * v) * (-0.72134752044f);
    f32x2 e; e.x = __builtin_amdgcn_exp2f(s.x); e.y = __builtin_amdgcn_exp2f(s.y);
    const f32x2 m = v * (q * e), r = v - m;
    f32x2 o; o.x = v.x < 0.f ? m.x : r.x; o.y = v.y < 0.f ? m.y : r.y; return o;
}

template <int ACT  > struct EpiBf16 {
    static constexpr bool PERM = true, AFTER_DRAIN = false; static_assert(ACT == 0 || ACT == 1, "EpiBf16: ACT is 0 (none) or 1 (gelu_pk)");
    bf16_t* O; int ldc; const float* bias; int split_cols; size_t split_stride; float scale0;
    __device__ __forceinline__ void operator()(const f32x4 (&acc)[2][2][4][2], const Unit& u, int wr, int wc, int fr, int fq) const {
        const int row0 = u.pm * BM + wr * 64 + fr; int colt = u.pn * BM; bf16_t* base = O;
        float sc = 1.f; if (split_cols) { const int t = colt / split_cols; base += (size_t)t * split_stride; colt -= t * split_cols; if (t == 0) sc = scale0; }
        const int col0 = colt + wc * 32 + 8 * fq, bcol0 = u.pn * BM + wc * 32 + 8 * fq;
        f32x4 bv[2][2];
#pragma unroll
        for (int bj = 0; bj < 2; ++bj)
#pragma unroll
            for (int n = 0; n < 2; ++n) bv[bj][n] = bias ? *(const f32x4*)(bias + bcol0 + bj * HALF + 4 * n) : (f32x4){0.f, 0.f, 0.f, 0.f};
#pragma unroll
        for (int ai = 0; ai < 2; ++ai)
#pragma unroll
            for (int m = 0; m < 4; ++m) { bf16_t* rowp = base + (size_t)(row0 + ai * HALF + m * 16) * ldc + col0;
#pragma unroll
                for (int bj = 0; bj < 2; ++bj) { f32x4 v0 = acc[ai][bj][m][0] + bv[bj][0], v1 = acc[ai][bj][m][1] + bv[bj][1];
                    if (ACT == 1) { f32x2 a = gelu_pk((f32x2){v0[0], v0[1]}), b = gelu_pk((f32x2){v0[2], v0[3]}), c = gelu_pk((f32x2){v1[0], v1[1]}), d = gelu_pk((f32x2){v1[2], v1[3]});
                        v0 = (f32x4){a.x, a.y, b.x, b.y}; v1 = (f32x4){c.x, c.y, d.x, d.y}; }
                    v0 = v0 * sc; v1 = v1 * sc; u32x4 w; w.x = cvt_pk_bf16(v0[0], v0[1]); w.y = cvt_pk_bf16(v0[2], v0[3]); w.z = cvt_pk_bf16(v1[0], v1[1]); w.w = cvt_pk_bf16(v1[2], v1[3]);
                    *(u32x4*)(rowp + bj * HALF) = w; } }
    }
};
template <class Epi, class Sched, bool ALIGN_EPI = false, bool SP2 = false>
__device__ __forceinline__ void gemm_phase(PG8_LAS unsigned char* lds, const Gemm g, const Sched& S, const Epi& E) {
    const int tid = tid_fresh(), wid = __builtin_amdgcn_readfirstlane(tid >> 6), lane = tid & 63, wr = wid >> 2, wc = wid & 3, fr = lane & 15, fq = lane >> 4;
    const int K = g.K, nt = K / BK;
    unsigned voffA[2], voffB[2];
#pragma unroll
    for (int i = 0; i < 2; ++i) { int R, C; stage_rc(tid * 16 + i * 8192, R, C); const int Rb = Epi::PERM ? ((R & ~31) + perm32(R & 31)) : R;
        voffA[i] = (unsigned)(R * K + C) * 2u; voffB[i] = (unsigned)(Rb * K + C) * 2u; }
    const size_t kstep = (size_t)(BK * 2);
    const size_t hstep = (size_t)HALF * K * 2;
    const size_t tstep = 2 * hstep;
    const unsigned ldsw = (unsigned)wid * 1024u;
    const int aoff = lds_byte(wr * 64 + fr, fq * 8), boff = lds_byte(wc * 32 + fr, fq * 8);
#define PG8_SA(b, h) (((b) * 2 + (h)) * HTB)
#define PG8_SB(b, h) ((4 + (b) * 2 + (h)) * HTB)
#define PG8_STAGE(bufoff, gbase, voff) do { _Pragma("unroll") for (int _i = 0; _i < 2; ++_i) \
        __builtin_amdgcn_global_load_lds((const unsigned*)((const char*)(gbase) + (voff)[_i]), (PG8_LAS unsigned*)(lds + (bufoff) + ldsw + _i * 8192), 16, 0, 0); } while (0)
#define PG8_LDA(dst, b, h) do { _Pragma("unroll") for (int m = 0; m < 4; ++m) _Pragma("unroll") for (int k = 0; k < 2; ++k) dst[m][k] = *(const PG8_LAS bf16x8*)(lds + PG8_SA(b, h) + aoff + m * 2048 + k * 1024); } while (0)
#define PG8_LDB(dst, b, h) do { _Pragma("unroll") for (int n = 0; n < 2; ++n) _Pragma("unroll") for (int k = 0; k < 2; ++k) dst[n][k] = *(const PG8_LAS bf16x8*)(lds + PG8_SB(b, h) + boff + n * 2048 + k * 1024); } while (0)
#define PG8_MMA(ai, bj, At, Bt) do { __builtin_amdgcn_s_setprio(1); _Pragma("unroll") for (int m = 0; m < 4; ++m) _Pragma("unroll") for (int n = 0; n < 2; ++n) _Pragma("unroll") for (int k = 0; k < 2; ++k) \
        acc[ai][bj][m][n] = __builtin_amdgcn_mfma_f32_16x16x32_bf16(Bt[n][k], At[m][k], acc[ai][bj][m][n], 0, 0, 0); __builtin_amdgcn_s_setprio(0); } while (0)
#define PG8_WAIT_V(n) asm volatile("s_waitcnt vmcnt(" #n ")" ::: "memory")
#define PG8_WAIT_L(n) asm volatile("s_waitcnt lgkmcnt(" #n ")" ::: "memory")
#define PG8_BAR __builtin_amdgcn_s_barrier()
#define PG8_SCHED __builtin_amdgcn_sched_barrier(0)
    Unit cur, nxt; int ui = 0;
    if (!S.next(0, cur)) return;
    f32x4 acc[2][2][4][2];
#pragma unroll
    for (int a = 0; a < 2; ++a)
#pragma unroll
        for (int b = 0; b < 2; ++b)
#pragma unroll
            for (int m = 0; m < 4; ++m)
#pragma unroll
                for (int n = 0; n < 2; ++n) acc[a][b][m][n] = (f32x4){0.f, 0.f, 0.f, 0.f};
    bf16x8 At[4][2], B0[2][2], B1[2][2];
    const char* cA = (const char*)g.A + (size_t)cur.pm * tstep; const char* cB = (const char*)g.Bt + (size_t)cur.pn * tstep;
    S.a_ready(cur);
    if constexpr (SP2) {
        PG8_STAGE(PG8_SB(0, 0), cB, voffB); PG8_STAGE(PG8_SB(0, 1), cB + hstep, voffB); PG8_STAGE(PG8_SA(0, 0), cA, voffA); PG8_STAGE(PG8_SA(0, 1), cA + hstep, voffA);
        if (wr == 1) PG8_BAR;
        PG8_WAIT_V(2); PG8_BAR;
        PG8_STAGE(PG8_SB(1, 0), cB + kstep, voffB); PG8_STAGE(PG8_SA(1, 0), cA + kstep, voffA); PG8_STAGE(PG8_SB(1, 1), cB + hstep + kstep, voffB);
        PG8_WAIT_V(6); PG8_BAR;
    } else {
        PG8_STAGE(PG8_SB(0, 0), cB, voffB); PG8_STAGE(PG8_SA(0, 0), cA, voffA); PG8_STAGE(PG8_SB(0, 1), cB + hstep, voffB); PG8_STAGE(PG8_SA(0, 1), cA + hstep, voffA);
        if (wr == 1) PG8_BAR;
        PG8_WAIT_V(4); PG8_BAR;
        PG8_STAGE(PG8_SB(1, 0), cB + kstep, voffB); PG8_STAGE(PG8_SA(1, 0), cA + kstep, voffA); PG8_STAGE(PG8_SB(1, 1), cB + hstep + kstep, voffB);
        PG8_WAIT_V(6); PG8_BAR;
    }
    for (;;) {
        const bool has_next = S.next(ui + 1, nxt);
        const char* nA = has_next ? (const char*)g.A + (size_t)nxt.pm * tstep : cA; const char* nB = has_next ? (const char*)g.Bt + (size_t)nxt.pn * tstep : cB;
        for (int t = 0; t < nt; t += 2) {
            const bool last = (t == nt - 2);
            const char* a1 = cA + (size_t)(t + 1) * kstep;
            const char* a2 = last ? nA : cA + (size_t)(t + 2) * kstep; const char* b2 = last ? nB : cB + (size_t)(t + 2) * kstep;
            const char* a3 = a2 + kstep; const char* b3 = b2 + kstep;
            if (last && has_next) S.a_ready(nxt);
            if constexpr (SP2) {
            PG8_LDB(B0, 0, 0); PG8_LDB(B1, 0, 1); PG8_SCHED; PG8_LDA(At, 0, 0); PG8_STAGE(PG8_SA(1, 1), a1 + hstep, voffA);
            PG8_WAIT_V(8); PG8_WAIT_L(0); PG8_BAR; PG8_MMA(0, 0, At, B0); PG8_MMA(0, 1, At, B1); PG8_BAR; PG8_SCHED;
            PG8_LDA(At, 0, 1); PG8_STAGE(PG8_SB(0, 0), b2, voffB); PG8_STAGE(PG8_SB(0, 1), b2 + hstep, voffB); PG8_STAGE(PG8_SA(0, 0), a2, voffA);
            PG8_WAIT_V(8); PG8_WAIT_L(0); PG8_BAR; PG8_MMA(1, 0, At, B0); PG8_MMA(1, 1, At, B1); PG8_BAR; PG8_SCHED;
            PG8_LDB(B0, 1, 0); PG8_LDB(B1, 1, 1); PG8_SCHED; PG8_LDA(At, 1, 0); PG8_STAGE(PG8_SA(0, 1), a2 + hstep, voffA);
            PG8_WAIT_V(8); PG8_WAIT_L(0); PG8_BAR; PG8_MMA(0, 0, At, B0); PG8_MMA(0, 1, At, B1); PG8_BAR; PG8_SCHED;
            PG8_LDA(At, 1, 1); PG8_STAGE(PG8_SB(1, 0), b3, voffB); PG8_STAGE(PG8_SB(1, 1), b3 + hstep, voffB); PG8_STAGE(PG8_SA(1, 0), a3, voffA);
            PG8_WAIT_V(8); PG8_WAIT_L(0); PG8_BAR; PG8_MMA(1, 0, At, B0); PG8_MMA(1, 1, At, B1); PG8_BAR; PG8_SCHED;
            } else {
            PG8_LDB(B0, 0, 0); PG8_SCHED; PG8_LDA(At, 0, 0); PG8_STAGE(PG8_SA(1, 1), a1 + hstep, voffA);
            PG8_WAIT_L(8); PG8_BAR; PG8_WAIT_L(0); PG8_MMA(0, 0, At, B0); PG8_BAR; PG8_SCHED;
            PG8_LDB(B1, 0, 1); PG8_STAGE(PG8_SB(0, 0), b2, voffB);
            PG8_BAR; PG8_WAIT_L(0); PG8_MMA(0, 1, At, B1); PG8_BAR;
            PG8_LDA(At, 0, 1); PG8_STAGE(PG8_SA(0, 0), a2, voffA);
            PG8_BAR; PG8_WAIT_L(0); PG8_MMA(1, 0, At, B0); PG8_BAR; PG8_SCHED;
            PG8_STAGE(PG8_SB(0, 1), b2 + hstep, voffB);
            PG8_WAIT_V(6); PG8_BAR; PG8_MMA(1, 1, At, B1); PG8_BAR;
            PG8_LDB(B0, 1, 0); PG8_SCHED; PG8_LDA(At, 1, 0); PG8_STAGE(PG8_SA(0, 1), a2 + hstep, voffA);
            PG8_WAIT_L(8); PG8_BAR; PG8_WAIT_L(0); PG8_MMA(0, 0, At, B0); PG8_BAR; PG8_SCHED;
            PG8_LDB(B1, 1, 1); PG8_STAGE(PG8_SB(1, 0), b3, voffB);
            PG8_BAR; PG8_WAIT_L(0); PG8_MMA(0, 1, At, B1); PG8_BAR;
            PG8_LDA(At, 1, 1); PG8_STAGE(PG8_SA(1, 0), a3, voffA);
            PG8_BAR; PG8_WAIT_L(0); PG8_MMA(1, 0, At, B0); PG8_BAR; PG8_SCHED;
            PG8_STAGE(PG8_SB(1, 1), b3 + hstep, voffB);
            PG8_WAIT_V(6); PG8_BAR; PG8_MMA(1, 1, At, B1); PG8_BAR;
            }
        }
        if constexpr (ALIGN_EPI) { if (wr == 0) PG8_BAR; }
        if constexpr (!Epi::AFTER_DRAIN) { E(acc, cur, wr, wc, fr, fq); S.done(cur); }
        if (!has_next) break;
#pragma unroll
        for (int a = 0; a < 2; ++a)
#pragma unroll
            for (int b = 0; b < 2; ++b)
#pragma unroll
                for (int m = 0; m < 4; ++m)
#pragma unroll
                    for (int n = 0; n < 2; ++n) acc[a][b][m][n] = (f32x4){0.f, 0.f, 0.f, 0.f};
        cur = nxt; cA = nA; cB = nB; ++ui;
        if constexpr (ALIGN_EPI) { if (wr == 1) PG8_BAR; }
    }
    PG8_WAIT_V(0);
    if constexpr (!ALIGN_EPI) { if (wr == 0) PG8_BAR; }
    PG8_BAR;
    if constexpr (Epi::AFTER_DRAIN) { E.fused(acc, cur, wr, wc, fr, fq, lds, wid, lane); S.done(cur); }
#undef PG8_SA
#undef PG8_SB
#undef PG8_STAGE
#undef PG8_LDA
#undef PG8_LDB
#undef PG8_MMA
#undef PG8_WAIT_V
#undef PG8_WAIT_L
#undef PG8_BAR
#undef PG8_SCHED
}
}

namespace pg8 {
struct EpiSwiglu {
    static constexpr bool PERM = true, AFTER_DRAIN = false;
    bf16_t* O; int ldc;
    __device__ __forceinline__ void operator()(const f32x4 (&acc)[2][2][4][2], const Unit& u, int wr, int wc, int fr, int fq) const {
        const int row0 = u.pm * BM + wr * 64 + fr; const int col0 = u.pn * HALF + wc * 32 + 8 * fq;
#pragma unroll
        for (int ai = 0; ai < 2; ++ai)
#pragma unroll
            for (int m = 0; m < 4; ++m) { bf16_t* rowp = O + (size_t)(row0 + ai * HALF + m * 16) * ldc + col0;
                float hv[8];
#pragma unroll
                for (int n = 0; n < 2; ++n)
#pragma unroll
                    for (int i = 0; i < 4; ++i) { const float g = acc[ai][0][m][n][i], up = acc[ai][1][m][n][i];
                        hv[n * 4 + i] = g * __builtin_amdgcn_rcpf(1.0f + __expf(-g)) * up; }
                u32x4 w; w.x = cvt_pk_bf16(hv[0], hv[1]); w.y = cvt_pk_bf16(hv[2], hv[3]); w.z = cvt_pk_bf16(hv[4], hv[5]); w.w = cvt_pk_bf16(hv[6], hv[7]);
                *(u32x4*)rowp = w; }
    }
};
}

#define LAS __attribute__((address_space(3)))
typedef unsigned short bf16;
typedef float f32x4 __attribute__((ext_vector_type(4)));
typedef short bf16x8 __attribute__((ext_vector_type(8)));
typedef short bf16x4 __attribute__((ext_vector_type(4)));
typedef unsigned v4u __attribute__((ext_vector_type(4)));
typedef unsigned v2u __attribute__((ext_vector_type(2)));

#define XB_TMO      128
#define XB_XCNT(j)  (256  + 64 * (j))
#define XB_XSUB(j)  (1280 + 64 * (j))
#define XB_XGEN(j)  (2304 + 64 * (j))
#define XB_TOP      3328
#define XB_TOPGEN   3392
#define XCD_BAR_WORDS 3456
#define XB_SPIN_CAP (1u << 18)

__device__ __forceinline__ unsigned xb_ld(unsigned* p)              { return __hip_atomic_load(p, __ATOMIC_RELAXED, __HIP_MEMORY_SCOPE_AGENT); }
__device__ __forceinline__ unsigned xb_add(unsigned* p, unsigned v) { return __hip_atomic_fetch_add(p, v, __ATOMIC_RELAXED, __HIP_MEMORY_SCOPE_AGENT); }
__device__ __forceinline__ unsigned xb_xcc_id() { return (unsigned)__builtin_amdgcn_s_getreg((3 << 11) | 20) & 0xFu; }
#define XB_SPIN(cond, bar) do { unsigned _sp = 0; while (cond) { __builtin_amdgcn_s_sleep(1); \
    if ((++_sp & 255u) == 0u) { if (xb_ld(&(bar)[XB_TMO])) break; if (_sp > XB_SPIN_CAP) { atomicAdd(&(bar)[XB_TMO], 1u); break; } } } } while (0)

struct XcdBarrier {
    unsigned* bar; unsigned x;
    volatile LAS unsigned* st;
};

__device__ __forceinline__ XcdBarrier xcd_barrier_post(unsigned* bar, volatile LAS unsigned* st) {
    XcdBarrier b; b.bar = bar; b.x = xb_xcc_id(); b.st = st;
    if (threadIdx.x == 0) (void)xb_add(&bar[XB_XCNT(b.x)], 1u);
    return b;
}
__device__ __forceinline__ void xcd_barrier_complete(unsigned* bar, unsigned x, unsigned& nloc, unsigned& nx) {
    const unsigned G = gridDim.x * gridDim.y * gridDim.z;
    unsigned sum, cnt, mine, sp = 0u;
    for (;;) {
        sum = 0u; cnt = 0u; mine = 0u;
#pragma unroll
        for (unsigned j = 0; j < 16; ++j) { const unsigned c = xb_ld(&bar[XB_XCNT(j)]); sum += c; cnt += (c > 0u) ? 1u : 0u; mine = (j == x) ? c : mine; }
        if (sum == G) break;
        __builtin_amdgcn_s_sleep(1);
        if ((++sp & 255u) == 0u) { if (xb_ld(&bar[XB_TMO])) break; if (sp > XB_SPIN_CAP) { atomicAdd(&bar[XB_TMO], 1u); break; } }
    }
    nloc = mine > 0u ? mine : 1u; nx = cnt > 0u ? cnt : 1u;
}

__device__ __forceinline__ void xcd_barrier(const XcdBarrier& b) {
    asm volatile("s_waitcnt vmcnt(0)" ::: "memory");
    __syncthreads();
    if (threadIdx.x == 0) {
        unsigned* bar = b.bar;
        __builtin_amdgcn_s_waitcnt(0);
        unsigned nloc = b.st[0], nx = b.st[1];
        if (nloc == 0u) { xcd_barrier_complete(bar, b.x, nloc, nx); b.st[0] = nloc; b.st[1] = nx; }
        const unsigned old = xb_add(&bar[XB_XSUB(b.x)], 1u);
        const unsigned gen = old / nloc;
        if (old + 1u == (gen + 1u) * nloc) {
            __builtin_amdgcn_fence(__ATOMIC_RELEASE, "agent");
            asm volatile("s_waitcnt vmcnt(0)" ::: "memory");
            const unsigned og = xb_add(&bar[XB_TOP], 1u);
            const unsigned tg = og / nx;
            if (og + 1u == (tg + 1u) * nx) xb_add(&bar[XB_TOPGEN], 1u);
            else XB_SPIN(xb_ld(&bar[XB_TOPGEN]) == tg, bar);
            __builtin_amdgcn_fence(__ATOMIC_ACQUIRE, "agent");
            xb_add(&bar[XB_XGEN(b.x)], 1u);
            asm volatile("s_waitcnt vmcnt(0)" ::: "memory");
        } else {
            XB_SPIN(xb_ld(&bar[XB_XGEN(b.x)]) == gen, bar);
            __builtin_amdgcn_fence(__ATOMIC_ACQUIRE, "agent");
            asm volatile("s_waitcnt vmcnt(0)" ::: "memory");
        }
    }
    __syncthreads();
}

constexpr int NROWS = 16896, NP = 16384, DM = 1024, DFF = 2816, ZW = 2816;
constexpr float EPS = 1e-6f;
constexpr size_t MiB = 1u << 20;
constexpr size_t WS_WGU1 = 0, WS_WD1 = 11 * MiB, WS_WIN = 17 * MiB, WS_WOUT = 23 * MiB, WS_WGU2 = 25 * MiB, WS_WD2 = 36 * MiB;
constexpr size_t WS_XN = 42 * MiB, WS_HZ = 75 * MiB, WS_Y = 166 * MiB, WS_CT = 199 * MiB, WS_NB = 231 * MiB, WS_GATES = 232 * MiB, WS_MST = 233 * MiB, WS_DEC = WS_MST + 65536, WS_CTL = 234 * MiB, WS_RS = 236 * MiB  ;
constexpr size_t O_YS = 16777216, O_PSK = 17301504, O_PSV = 17334272, O_PC = 17367040, O_PN = 17498112, O_PM = 17499136,
                 O_SSK = 17499144, O_SSV = 19596296, O_SC = 21693448, O_SN = 30082056, O_SM = 30147592;
constexpr int LDS_BYTES = 131072 + 1024;

struct Params { const float* in[16]; float* out; unsigned char* ws; };

__device__ __forceinline__ unsigned f2bf_sw(float f) { unsigned u = __builtin_bit_cast(unsigned, f); return (u + 0x7fffu + ((u >> 16) & 1u)) >> 16; }
__device__ __forceinline__ unsigned pk2_sw(float lo, float hi) { return f2bf_sw(lo) | (f2bf_sw(hi) << 16); }
__device__ __forceinline__ unsigned pk2(float lo, float hi) { unsigned r; asm("s_nop 0\n\tv_cvt_pk_bf16_f32 %0, %1, %2\n\ts_nop 1" : "=v"(r) : "v"(lo), "v"(hi)); return r; }
__device__ __forceinline__ unsigned f2bf(float f) { return pk2(f, 0.f) & 0xffffu; }
__device__ __forceinline__ float bf2f(unsigned b) { return __builtin_bit_cast(float, b << 16); }
__device__ __forceinline__ float bflo(unsigned w) { return __builtin_bit_cast(float, w << 16); }
__device__ __forceinline__ float bfhi(unsigned w) { return __builtin_bit_cast(float, w & 0xffff0000u); }
#define DPP_F(v, ctrl) __builtin_bit_cast(float, __builtin_amdgcn_update_dpp(0, __builtin_bit_cast(int, (v)), (ctrl), 0xF, 0xF, true))
#define RDL_F(v, l) __builtin_bit_cast(float, __builtin_amdgcn_readlane(__builtin_bit_cast(int, (v)), (l)))
__device__ __forceinline__ float wave_sum(float v) {
    v += DPP_F(v, 0xB1); v += DPP_F(v, 0x4E); v += DPP_F(v, 0x141); v += DPP_F(v, 0x140);
    return (RDL_F(v, 0) + RDL_F(v, 16)) + (RDL_F(v, 32) + RDL_F(v, 48));
}
__device__ __forceinline__ float wave_max(float v) {
    v = fmaxf(v, DPP_F(v, 0xB1)); v = fmaxf(v, DPP_F(v, 0x4E)); v = fmaxf(v, DPP_F(v, 0x141)); v = fmaxf(v, DPP_F(v, 0x140));
    return fmaxf(fmaxf(RDL_F(v, 0), RDL_F(v, 16)), fmaxf(RDL_F(v, 32), RDL_F(v, 48)));
}
__device__ __forceinline__ float row16_sum(float v) { v += DPP_F(v, 0xB1); v += DPP_F(v, 0x4E); v += DPP_F(v, 0x141); v += DPP_F(v, 0x140); return v; }
__device__ __forceinline__ float row8_sum(float v) { v += DPP_F(v, 0xB1); v += DPP_F(v, 0x4E); v += DPP_F(v, 0x141); return v; }
#define DPP_FO(idv, v, ctrl, rm) __builtin_bit_cast(float, __builtin_amdgcn_update_dpp(__builtin_bit_cast(int, (float)(idv)), __builtin_bit_cast(int, (v)), (ctrl), (rm), 0xF, false))
__device__ __forceinline__ float scan_sum(float v, int lane) {
    v += DPP_FO(0.f, v, 0x111, 0xF); v += DPP_FO(0.f, v, 0x112, 0xF); v += DPP_FO(0.f, v, 0x114, 0xF); v += DPP_FO(0.f, v, 0x118, 0xF);
    v += DPP_FO(0.f, v, 0x142, 0xA); v += DPP_FO(0.f, v, 0x143, 0xC);
    return v;
}
__device__ __forceinline__ float scan_max(float v, int lane) {
    v = fmaxf(v, DPP_FO(-INFINITY, v, 0x111, 0xF)); v = fmaxf(v, DPP_FO(-INFINITY, v, 0x112, 0xF)); v = fmaxf(v, DPP_FO(-INFINITY, v, 0x114, 0xF)); v = fmaxf(v, DPP_FO(-INFINITY, v, 0x118, 0xF));
    v = fmaxf(v, DPP_FO(-INFINITY, v, 0x142, 0xA)); v = fmaxf(v, DPP_FO(-INFINITY, v, 0x143, 0xC));
    return v;
}
__device__ __forceinline__ float logsig(float x) { return fminf(x, 0.f) - 0.6931471805599453f * __builtin_amdgcn_logf(1.0f + __builtin_amdgcn_exp2f(fabsf(x) * -1.4426950408889634f)); }
__device__ __forceinline__ bf16x8 cat4(bf16x4 a, bf16x4 b) { bf16x8 r; r[0] = a[0]; r[1] = a[1]; r[2] = a[2]; r[3] = a[3]; r[4] = b[0]; r[5] = b[1]; r[6] = b[2]; r[7] = b[3]; return r; }
__device__ __forceinline__ bf16x8 pack8(f32x4 a, f32x4 b) {
    v4u w; w.x = pk2(a[0], a[1]); w.y = pk2(a[2], a[3]); w.z = pk2(b[0], b[1]); w.w = pk2(b[2], b[3]);
    return __builtin_bit_cast(bf16x8, w);
}
__device__ __forceinline__ bf16x8 tr_frag(const LAS bf16* a0, const LAS bf16* a1) {
    const bf16x4 lo = __builtin_amdgcn_ds_read_tr16_b64_v4i16((LAS bf16x4*)a0), hi = __builtin_amdgcn_ds_read_tr16_b64_v4i16((LAS bf16x4*)a1); return cat4(lo, hi); }
#define MFMA16(a, b, c) __builtin_amdgcn_mfma_f32_16x16x32_bf16((a), (b), (c), 0, 0, 0)
#define VELEM(v, e) (((v)[(e) >> 1] >> (16 * ((e) & 1))) & 0xffffu)

__device__ __forceinline__ void tr_item(const float* W, int ld, int k0, int ncol, bf16* WT, int K, int drow, float scale, const float* gk, LAS float* scr, int lane) {
#pragma unroll
    for (int i = 0; i < 32; ++i) { const int kk = 2 * i + (lane >> 5); scr[kk * 33 + (lane & 31)] = __builtin_nontemporal_load(&W[(size_t)(k0 + kk) * ld + ncol + (lane & 31)]) * scale; }
    asm volatile("s_waitcnt lgkmcnt(0)" ::: "memory");
    const int c = lane & 7;
    f32x4 ga = {1.f, 1.f, 1.f, 1.f}, gb = {1.f, 1.f, 1.f, 1.f}; if (gk) { ga = *(const f32x4*)(gk + k0 + 8 * c); gb = *(const f32x4*)(gk + k0 + 8 * c + 4); }
#pragma unroll
    for (int j = 0; j < 4; ++j) { const int n = (lane >> 3) + 8 * j; const LAS float* s = scr + (8 * c) * 33 + n;
        v4u o; o.x = pk2(s[0 * 33] * ga[0], s[1 * 33] * ga[1]); o.y = pk2(s[2 * 33] * ga[2], s[3 * 33] * ga[3]); o.z = pk2(s[4 * 33] * gb[0], s[5 * 33] * gb[1]); o.w = pk2(s[6 * 33] * gb[2], s[7 * 33] * gb[3]);
        *(v4u*)(WT + (size_t)(drow + n) * K + k0 + 8 * c) = o; }
    asm volatile("s_waitcnt lgkmcnt(0)" ::: "memory");
}

__device__ __forceinline__ void conv_item(const Params& p, LAS float* scr, int lane, int mat, int r) {
    unsigned char* ws = p.ws;
    const float* src; int ld, K, k0, ncol, drow; bf16* dst; float scale = 1.f;
    const float* gk = (mat == 0 || mat == 1) ? p.in[7] : (mat == 3 ? p.in[7] + 2 * DM : ((mat == 4 || mat == 5) ? p.in[7] + 4 * DM : nullptr));
    if (mat == 2 || mat == 6) { const int l = (mat == 6); const int kb = r >> 5, nb = r & 31; src = p.in[10] + (size_t)l * 2816 * 1024; ld = 1024; K = 2816; k0 = kb * 64; ncol = nb * 32; drow = ncol;
        dst = (bf16*)(ws + (l ? WS_WD2 : WS_WD1)); }
    else if (mat == 3) { const int kb = r / 88, nb = r - kb * 88; src = p.in[11]; ld = 2824; K = 1024; k0 = kb * 64; const int zc = nb * 32; ncol = zc + (zc >= 2048 ? 8 : 0); drow = zc; dst = (bf16*)(ws + WS_WIN);
        scale = (zc >= 512 && zc < 1024) ? 0.08838834764831845f : ((zc >= 2048 && zc < 2560) ? 0.125f : 1.f); }
    else if (mat == 7) { const int kb = r >> 5, nb = r & 31; src = p.in[15]; ld = 1024; K = 1024; k0 = kb * 64; ncol = nb * 32; drow = ncol; dst = (bf16*)(ws + WS_WOUT); }
    else { const int l = (mat >= 4), up = (mat & 1); const int kb = r / 88, nb = r - kb * 88; src = (up ? p.in[9] : p.in[8]) + (size_t)l * 1024 * 2816; ld = 2816; K = 1024; k0 = kb * 64; ncol = nb * 32;
        drow = 256 * (ncol >> 7) + (ncol & 127) + 128 * up; dst = (bf16*)(ws + (l ? WS_WGU2 : WS_WGU1)); }
    tr_item(src, ld, k0, ncol, dst, K, drow, scale, gk, scr, lane);
}
__device__ __forceinline__ void conv_tail_a(const Params& p, LAS unsigned char* L, int gwi, int ngwi) {
    const int tid = tid_fresh(), lane = tid & 63, wave = tid >> 6; LAS float* scr = (LAS float*)(L + wave * 16384);
    for (int it = gwi * 8 + wave; it < 3328; it += ngwi * 8) { if (it < 1408) conv_item(p, scr, lane, 3, it); else if (it < 2816) conv_item(p, scr, lane, 6, it - 1408); else conv_item(p, scr, lane, 7, it - 2816); }
    __syncthreads();
}

__device__ __forceinline__ void prologue(const Params& p, LAS unsigned char* L) {
    const int tid = tid_fresh(), lane = tid & 63, wave = tid >> 6;
    LAS float* scr = (LAS float*)(L + wave * 16384);
    const int gw = blockIdx.x * 8 + wave, NGW = gridDim.x * 8;
    unsigned char* ws = p.ws;
    for (int it = gw; it < 4224; it += NGW) { const int mat = it / 1408; conv_item(p, scr, lane, mat, it - mat * 1408); }
    const f32x4* g0 = (const f32x4*)(p.in[7]);
    f32x4 gv[4];
#pragma unroll
    for (int j = 0; j < 4; ++j) gv[j] = g0[64 * j + lane];
    bf16* XN = (bf16*)(ws + WS_XN);
    f32x4 v[4], vn[4];
#define PX_LOAD(R, V) do { const int r_ = (R); const float* xin = r_ < NP ? p.in[0] + (size_t)r_ * DM : p.in[1] + (size_t)(r_ - NP) * DM; _Pragma("unroll") for (int j = 0; j < 4; ++j) V[j] = __builtin_nontemporal_load(&((const f32x4*)xin)[64 * j + lane]); } while (0)
    PX_LOAD(gw < NROWS ? gw : 0, v);
    for (int r = gw; r < NROWS; r += NGW) {
        PX_LOAD((r + NGW) < NROWS ? (r + NGW) : r, vn);
        float ss = 0.f;
#pragma unroll
        for (int j = 0; j < 4; ++j) ss += (v[j][0] * v[j][0] + v[j][1] * v[j][1]) + (v[j][2] * v[j][2] + v[j][3] * v[j][3]);
        const float m0 = wave_sum(ss) * (1.f / DM) + EPS; const float rs = __builtin_amdgcn_rsqf(m0);
        if (lane == 0) ((float*)(ws + WS_RS))[2 * NROWS + r] = __builtin_amdgcn_sqrtf(m0);
        v2u* o = (v2u*)(XN + (size_t)r * DM);
#pragma unroll
        for (int j = 0; j < 4; ++j) { v2u w; w.x = pk2(v[j][0] * rs, v[j][1] * rs); w.y = pk2(v[j][2] * rs, v[j][3] * rs); o[64 * j + lane] = w; }
#pragma unroll
        for (int j = 0; j < 4; ++j) v[j] = vn[j];
    }
#undef PX_LOAD
}

template <bool FIRST, bool LAST, bool GATES>
__device__ __forceinline__ void row_pass(const Params& p, LAS unsigned char* L, float coef, int gpost, int gpre, const bf16* xb_in, bf16* xb_out, const float* ir_in, float* ir_out) {
    const int tid = tid_fresh(), lane = tid & 63, wave = tid >> 6;
    const int gw = blockIdx.x * 8 + wave, NGW = gridDim.x * 8;
    unsigned char* ws = p.ws;
    LAS f32x4* GWa = (LAS f32x4*)L; LAS f32x4* GWb = (LAS f32x4*)(L + 16384);
    if (GATES) {
        const float* win = p.in[11];
        for (int idx = tid; idx < 8192; idx += 512) { const int k = idx >> 3, g = idx & 7; const float val = win[(size_t)k * 2824 + 2048 + g];
            const int j = k >> 8, ln = (k & 255) >> 2, i = k & 3; const int kk = (j * 4 + i) * 64 + ln;
            ((LAS float*)L)[(g < 4 ? 0 : 4096) + kk * 4 + (g & 3)] = val; }
        __syncthreads();
    }
    f32x4 gp[4], gq[4];
#pragma unroll
    for (int j = 0; j < 4; ++j) { gp[j] = ((const f32x4*)(p.in[7] + gpost * DM))[64 * j + lane] * coef; gq[j] = LAST ? gp[j] : ((const f32x4*)(p.in[7] + gpre * DM))[64 * j + lane]; }
    const bf16* Y = (const bf16*)(ws + WS_Y); float* GA = (float*)(ws + WS_GATES);
    f32x4 xf[4], xfn[4]; v2u xh[4], xhn[4]; v2u yr[4], ynx[4];
#define RP_LOAD(R, XF, XH, YR) do { const int r_ = (R); \
        if (FIRST) { const float* xin = r_ < NP ? p.in[0] + (size_t)r_ * DM : p.in[1] + (size_t)(r_ - NP) * DM; _Pragma("unroll") for (int j = 0; j < 4; ++j) XF[j] = ((const f32x4*)xin)[64 * j + lane]; } \
        else { _Pragma("unroll") for (int j = 0; j < 4; ++j) XH[j] = ((const v2u*)(xb_in + (size_t)r_ * DM))[64 * j + lane]; } \
        _Pragma("unroll") for (int j = 0; j < 4; ++j) YR[j] = ((const v2u*)(Y + (size_t)r_ * DM))[64 * j + lane]; } while (0)
    RP_LOAD(gw < NROWS ? gw : 0, xf, xh, yr);
    float irc = FIRST ? 1.f : ir_in[gw < NROWS ? gw : 0];
    for (int r = gw; r < NROWS; r += NGW) {
        RP_LOAD((r + NGW) < NROWS ? (r + NGW) : r, xfn, xhn, ynx);
        const float irn = FIRST ? 1.f : ir_in[(r + NGW) < NROWS ? (r + NGW) : r];
        f32x4 xv[4], yv[4]; float ss = 0.f;
#pragma unroll
        for (int j = 0; j < 4; ++j) { const v2u yy = yr[j];
            xv[j] = FIRST ? xf[j] : (f32x4){bflo(xh[j].x), bfhi(xh[j].x), bflo(xh[j].y), bfhi(xh[j].y)} * irc;
            yv[j] = (f32x4){bflo(yy.x), bfhi(yy.x), bflo(yy.y), bfhi(yy.y)}; ss += (yv[j][0] * yv[j][0] + yv[j][1] * yv[j][1]) + (yv[j][2] * yv[j][2] + yv[j][3] * yv[j][3]); }
        const float r1 = __builtin_amdgcn_rsqf(wave_sum(ss) * (1.f / DM) + EPS);
        float s2 = 0.f;
#pragma unroll
        for (int j = 0; j < 4; ++j) { xv[j] = xv[j] + yv[j] * r1 * gp[j];
            if (LAST) __builtin_nontemporal_store(xv[j], &((f32x4*)(p.out + (size_t)r * DM))[64 * j + lane]);
            s2 += (xv[j][0] * xv[j][0] + xv[j][1] * xv[j][1]) + (xv[j][2] * xv[j][2] + xv[j][3] * xv[j][3]); }
        if (!LAST) {
            const float m2 = wave_sum(s2) * (1.f / DM) + EPS; const float r2 = __builtin_amdgcn_rsqf(m2);
            v2u* o = (v2u*)(xb_out + (size_t)r * DM);
#pragma unroll
            for (int j = 0; j < 4; ++j) { xv[j] = xv[j] * r2; v2u w; w.x = pk2(xv[j][0], xv[j][1]); w.y = pk2(xv[j][2], xv[j][3]); o[64 * j + lane] = w; }
            if (lane == 0) ir_out[r] = __builtin_amdgcn_sqrtf(m2);
            if (GATES) {
#pragma unroll
                for (int j = 0; j < 4; ++j) xv[j] = xv[j] * gq[j];
                f32x4 ga = {0.f, 0.f, 0.f, 0.f}, gb = {0.f, 0.f, 0.f, 0.f};
#pragma unroll
                for (int j = 0; j < 4; ++j)
#pragma unroll
                    for (int i = 0; i < 4; ++i) { const int kk = (j * 4 + i) * 64 + lane; ga += GWa[kk] * xv[j][i]; gb += GWb[kk] * xv[j][i]; }
#pragma unroll
                for (int i = 0; i < 4; ++i) { ga[i] = wave_sum(ga[i]); gb[i] = wave_sum(gb[i]); }
                if (lane == 0) { const f32x4 b0 = ((const f32x4*)p.in[12])[0], b1 = ((const f32x4*)p.in[12])[1]; ((f32x4*)(GA + (size_t)r * 8))[0] = ga + b0; ((f32x4*)(GA + (size_t)r * 8))[1] = gb + b1; }
            }
        }
#pragma unroll
        for (int j = 0; j < 4; ++j) { if (FIRST) xf[j] = xfn[j]; else xh[j] = xhn[j]; yr[j] = ynx[j]; }
        irc = irn;
    }
#undef RP_LOAD
    if (GATES) __syncthreads();
}

__device__ __forceinline__ void stats_item(const Params& p, LAS unsigned char* L, int bh) {
    const int tid = tid_fresh(), lane = tid & 63, wave = tid >> 6; const int b = bh >> 2, h = bh & 3;
    LAS float* sBL = (LAS float*)L; LAS float* sGM = (LAS float*)(L + 512);
    const float* GA = (const float*)(p.ws + WS_GATES);
    float igv[16], fgv[16];
#pragma unroll
    for (int ci = 0; ci < 16; ++ci) { const int ch = wave + 8 * ci; const size_t row = (size_t)b * 8192 + ch * 64 + lane; igv[ci] = GA[row * 8 + h]; fgv[ci] = GA[row * 8 + 4 + h]; }
#pragma unroll
    for (int ci = 0; ci < 16; ++ci) { const int ch = wave + 8 * ci;
        const float bc = scan_sum(logsig(fgv[ci]), lane); const float bL = RDL_F(bc, 63); const float gm = wave_max(bL - bc + igv[ci]);
        if (lane == 0) { sBL[ch] = bL; sGM[ch] = gm; } }
    __syncthreads();
    if (wave == 0) {
        const float a0 = sBL[2 * lane], b0 = sGM[2 * lane], a1 = sBL[2 * lane + 1], b1 = sGM[2 * lane + 1];
        float A = a0 + a1, B = fmaxf(b0 + a1, b1);
#pragma unroll
        for (int o = 1; o < 64; o <<= 1) { const float Ap = __shfl_up(A, o), Bp = __shfl_up(B, o); if (lane >= o) { B = fmaxf(Bp + A, B); A = Ap + A; } }
        float Ae = __shfl_up(A, 1), Be = __shfl_up(B, 1); if (lane == 0) { Ae = 0.f; Be = -INFINITY; }
        const float m_in0 = fmaxf(Ae, Be);
        const float m_in1 = fmaxf(m_in0 + a0, b0);
        const float m_out = fmaxf(m_in1 + a1, b1);
        float* MST = (float*)(p.ws + WS_MST) + bh * 132; float* DEC = (float*)(p.ws + WS_DEC) + bh * 128;
        MST[2 * lane] = lane == 0 ? 0.f : m_in0; MST[2 * lane + 1] = m_in1; if (lane == 63) { MST[128] = m_out; p.out[O_PM + bh] = m_out; }
        DEC[2 * lane] = __expf(a0 + (lane == 0 ? 0.f : m_in0) - m_in1); DEC[2 * lane + 1] = __expf(a1 + m_in1 - m_out);
    }
    __syncthreads();
}

__device__ __forceinline__ void mlstm_dcs_phase(const Params& p, LAS unsigned char* L) {
    const int tid = tid_fresh(), lane = tid & 63, wave = tid >> 6, r16 = lane & 15, quad = lane >> 4;
    LAS bf16* sK = (LAS bf16*)L; LAS bf16* sV = (LAS bf16*)(L + 18432); LAS float* sWK = (LAS float*)(L + 36864);
    const int trq = (lane & 15) >> 2, trp = lane & 3;
    const bf16* Z = (const bf16*)(p.ws + WS_HZ); const float* GA = (const float*)(p.ws + WS_GATES); const float* MST = (const float*)(p.ws + WS_MST); const float* DEC = (const float*)(p.ws + WS_DEC);
    v4u kq[2], vq[2]; float ig = 0.f, fg = 0.f, mn = 0.f;
#define DC_LOAD(IT) do { const int bh_ = (IT) >> 7, ch_ = (IT) & 127; const int row0_ = (bh_ >> 2) * 8192 + ch_ * 64, h_ = bh_ & 3; \
        _Pragma("unroll") for (int i = 0; i < 2; ++i) { const int pc = tid + 512 * i, t = pc >> 4, piece = pc & 15; const bf16* zr = Z + (size_t)(row0_ + t) * ZW + h_ * 128 + piece * 8; kq[i] = *(const v4u*)(zr + 512); vq[i] = *(const v4u*)(zr + 1024); } \
        if (wave == 0) { const size_t row = (size_t)row0_ + lane; ig = GA[row * 8 + h_]; fg = GA[row * 8 + 4 + h_]; mn = MST[bh_ * 132 + ch_ + 1]; } } while (0)
    for (int unit = blockIdx.x; unit < 256; unit += gridDim.x) {
        const int bh = unit >> 5, sc = unit & 31;
        f32x4 acc[8]; float nacc = 0.f;
#pragma unroll
        for (int mi = 0; mi < 8; ++mi) acc[mi] = (f32x4){0.f, 0.f, 0.f, 0.f};
        DC_LOAD(bh * 128 + 4 * sc);
        for (int j = 0; j < 4; ++j) {
            const int ch = 4 * sc + j;
            if (wave == 0) { const float bc = scan_sum(logsig(fg), lane); const float bL = RDL_F(bc, 63); sWK[lane] = __expf(bL - bc + ig - mn); }
            __syncthreads();
#pragma unroll
            for (int i = 0; i < 2; ++i) { const int pc = tid + 512 * i, t = pc >> 4, piece = pc & 15; const float wk = sWK[t]; v4u ks;
#pragma unroll
                for (int w = 0; w < 4; ++w) ks[w] = pk2(bflo(kq[i][w]) * wk, bfhi(kq[i][w]) * wk);
                *(LAS v4u*)(sK + t * 144 + piece * 8) = ks; *(LAS v4u*)(sV + t * 144 + piece * 8) = vq[i]; }
            __syncthreads();
            if (j < 3) DC_LOAD(bh * 128 + ch + 1);
            __builtin_amdgcn_sched_barrier(0);
            const float dec = DEC[bh * 128 + ch];
#pragma unroll
            for (int mi = 0; mi < 8; ++mi) acc[mi] = acc[mi] * dec;
#pragma unroll
            for (int kk = 0; kk < 2; ++kk) { const int rb = (32 * kk + 8 * quad + trq) * 144 + 4 * trp; const bf16x8 bfr = tr_frag(sV + rb + 16 * wave, sV + rb + 4 * 144 + 16 * wave);
#pragma unroll
                for (int mi = 0; mi < 8; ++mi) { const bf16x8 afr = tr_frag(sK + rb + 16 * mi, sK + rb + 4 * 144 + 16 * mi); acc[mi] = MFMA16(afr, bfr, acc[mi]); } }
            if (tid < 128) { float s = 0.f;
#pragma unroll 8
                for (int t = 0; t < 64; ++t) s += bf2f(sK[t * 144 + tid]);
                nacc = nacc * dec + s; }
            __syncthreads();
        }
        bf16* ct = (bf16*)(p.ws + WS_CT) + (((size_t)(bh * 128 + 16 * wave + r16) * 32 + sc) << 7);
#pragma unroll
        for (int mi = 0; mi < 8; ++mi) { v2u o; o.x = pk2_sw(acc[mi][0], acc[mi][1]); o.y = pk2_sw(acc[mi][2], acc[mi][3]); *(v2u*)(ct + 16 * mi + 4 * quad) = o; }
        if (tid < 128) ((float*)(p.ws + WS_NB))[(size_t)(bh * 32 + sc) * 128 + tid] = nacc;
    }
#undef DC_LOAD
}

__device__ __forceinline__ void swa_prompt_item(const Params& p, LAS unsigned char* L, int item) {
    const int tid = tid_fresh(), lane = tid & 63, wave = tid >> 6, r16 = lane & 15, quad = lane >> 4;
    const int b = item >> 7, nb = (item >> 1) & 63, kvh = item & 1;
    LAS bf16* sK = (LAS bf16*)L; LAS bf16* sVT = (LAS bf16*)(L + 36864);
    const bf16* Z = (const bf16*)(p.ws + WS_HZ); bf16* U = (bf16*)(p.ws + WS_XN);
#pragma unroll
    for (int i = 0; i < 4; ++i) { const int pc = tid + 512 * i, j = pc >> 3, piece = pc & 7; const int pos = nb * 128 - 128 + j;
        v4u kq = {0u, 0u, 0u, 0u}, vq = {0u, 0u, 0u, 0u};
        if (pos >= 0) { const bf16* zr = Z + (size_t)(b * 8192 + pos) * ZW + kvh * 64 + piece * 8; kq = *(const v4u*)(zr + 2560); vq = *(const v4u*)(zr + 2688); }
        *(LAS v4u*)(sK + j * 72 + piece * 8) = kq; *(LAS v4u*)(sVT + j * 72 + piece * 8) = vq;
        if (nb == 63 && j >= 128) { const size_t o = ((size_t)((b * 128 + (j - 128)) * 2 + kvh)) * 64 + piece * 8; float* ok = p.out + O_PSK + o; float* ov = p.out + O_PSV + o;
            ((f32x4*)ok)[0] = (f32x4){bflo(kq.x), bfhi(kq.x), bflo(kq.y), bfhi(kq.y)}; ((f32x4*)ok)[1] = (f32x4){bflo(kq.z), bfhi(kq.z), bflo(kq.w), bfhi(kq.w)};
            ((f32x4*)ov)[0] = (f32x4){bflo(vq.x), bfhi(vq.x), bflo(vq.y), bfhi(vq.y)}; ((f32x4*)ov)[1] = (f32x4){bflo(vq.z), bfhi(vq.z), bflo(vq.w), bfhi(vq.w)}; } }
    bf16x8 qn0, qn1;
    { const int rt = wave * 4, g = rt >> 3, qt = rt & 7, hh = kvh * 4 + g;
        const size_t qrow = (size_t)b * 8192 + nb * 128 + 16 * qt + r16; const bf16* qp = Z + qrow * ZW + 2048 + hh * 64 + 8 * quad; qn0 = *(const bf16x8*)qp; qn1 = *(const bf16x8*)(qp + 32); }
    __syncthreads();
#pragma nounroll
    for (int i = 0; i < 4; ++i) { const int rt = wave * 4 + i, g = rt >> 3, qt = rt & 7, hh = kvh * 4 + g; const int kt0 = qt < 6 ? qt : 6;
        const bf16x8 qf0 = qn0, qf1 = qn1;
        if (i < 3) { const int rt2 = rt + 1, g2 = rt2 >> 3, qt2 = rt2 & 7, hh2 = kvh * 4 + g2;
            const size_t qrow = (size_t)b * 8192 + nb * 128 + 16 * qt2 + r16; const bf16* qp = Z + qrow * ZW + 2048 + hh2 * 64 + 8 * quad; qn0 = *(const bf16x8*)qp; qn1 = *(const bf16x8*)(qp + 32); }
        f32x4 s[10];
#pragma unroll
        for (int kt = 0; kt < 10; ++kt) { const LAS bf16* kp = sK + (16 * (kt0 + kt) + r16) * 72 + 8 * quad; const bf16x8 k0 = *(const LAS bf16x8*)kp, k1 = *(const LAS bf16x8*)(kp + 32);
            s[kt] = MFMA16(k0, qf0, ((f32x4){0.f, 0.f, 0.f, 0.f})); s[kt] = MFMA16(k1, qf1, s[kt]); }
        const float slope = __uint_as_float((unsigned)(126 - hh) << 23)  , sink = p.in[14][hh]; const int qi = 16 * qt + r16; float mx = sink;
        const float fd0 = (float)(128 + qi - 16 * kt0 - 4 * quad); const unsigned limb = __float_as_uint((float)(nb > 0 ? 128 : (qi + 1 < 128 ? qi + 1 : 128)));
#pragma unroll
        for (int kt = 0; kt < 10; ++kt)
#pragma unroll
            for (int rg = 0; rg < 4; ++rg) { const float fdist = fd0 - (float)(16 * kt + rg); const bool valid = __float_as_uint(fdist) < limb;
                const float v = valid ? s[kt][rg] - slope * fdist : -INFINITY; s[kt][rg] = v; mx = fmaxf(mx, v); }
        mx = fmaxf(mx, __shfl_xor(mx, 16)); mx = fmaxf(mx, __shfl_xor(mx, 32));
        float sum = 0.f;
#pragma unroll
        for (int kt = 0; kt < 10; ++kt)
#pragma unroll
            for (int rg = 0; rg < 4; ++rg) { const float e = __expf(s[kt][rg] - mx); s[kt][rg] = e; sum += e; }
        sum += __shfl_xor(sum, 16); sum += __shfl_xor(sum, 32);
        const float inv = __builtin_amdgcn_rcpf(sum + __expf(sink - mx));
        f32x4 o[4];
#pragma unroll
        for (int nd = 0; nd < 4; ++nd) o[nd] = (f32x4){0.f, 0.f, 0.f, 0.f};
#pragma unroll
        for (int i2 = 0; i2 < 5; ++i2) { const bf16x8 pa = pack8(s[2 * i2], s[2 * i2 + 1]);
#pragma unroll
            for (int nd = 0; nd < 4; ++nd) { const LAS bf16* vp = sVT + (16 * (kt0 + 2 * i2) + 4 * quad + ((lane & 15) >> 2)) * 72 + 16 * nd + 4 * (lane & 3);
                const bf16x8 vb = tr_frag(vp, vp + 16 * 72); o[nd] = MFMA16(pa, vb, o[nd]); } }
#pragma unroll
        for (int rg = 0; rg < 4; ++rg) { const float iv = __shfl(inv, 4 * quad + rg); const size_t orow = (size_t)b * 8192 + nb * 128 + 16 * qt + 4 * quad + rg;
#pragma unroll
            for (int nd = 0; nd < 4; ++nd) U[orow * DM + 512 + hh * 64 + 16 * nd + r16] = (bf16)f2bf(o[nd][rg] * iv); }
    }
    __syncthreads();
}

__device__ __forceinline__ void swa_sample_item(const Params& p, LAS unsigned char* L, int item) {
    const int tid = tid_fresh(), lane = tid & 63, wave = tid >> 6, r16 = lane & 15, quad = lane >> 4; const int bd = item >> 1, kvh = item & 1; const int row0 = NP + bd * 4;
    LAS bf16* sK = (LAS bf16*)L;
    LAS bf16* sV = (LAS bf16*)(L + 23040);
    const bf16* Z = (const bf16*)(p.ws + WS_HZ); bf16* U = (bf16*)(p.ws + WS_XN);
#pragma unroll
    for (int i = 0; i < 3; ++i) { const int pc = tid + 512 * i; if (pc < 1280) { const int j = pc >> 3, piece = pc & 7; v4u kq = {0u, 0u, 0u, 0u}, vq = {0u, 0u, 0u, 0u};
            if (j < 128) { const size_t o = ((size_t)((bd * 128 + j) * 2 + kvh)) * 64 + piece * 8;
                const f32x4 k0 = __builtin_nontemporal_load((const f32x4*)(p.in[2] + o)), k1 = __builtin_nontemporal_load((const f32x4*)(p.in[2] + o + 4)), v0 = __builtin_nontemporal_load((const f32x4*)(p.in[3] + o)), v1 = __builtin_nontemporal_load((const f32x4*)(p.in[3] + o + 4));
                kq.x = pk2(k0[0], k0[1]); kq.y = pk2(k0[2], k0[3]); kq.z = pk2(k1[0], k1[1]); kq.w = pk2(k1[2], k1[3]);
                vq.x = pk2(v0[0], v0[1]); vq.y = pk2(v0[2], v0[3]); vq.z = pk2(v1[0], v1[1]); vq.w = pk2(v1[2], v1[3]);
                if (j >= 4) { const size_t oo = o - 4 * 128; __builtin_nontemporal_store(k0, (f32x4*)(p.out + O_SSK + oo)); __builtin_nontemporal_store(k1, (f32x4*)(p.out + O_SSK + oo + 4)); __builtin_nontemporal_store(v0, (f32x4*)(p.out + O_SSV + oo)); __builtin_nontemporal_store(v1, (f32x4*)(p.out + O_SSV + oo + 4)); } }
            else if (j < 132) { const bf16* zr = Z + (size_t)(row0 + j - 128) * ZW + kvh * 64 + piece * 8; kq = *(const v4u*)(zr + 2560); vq = *(const v4u*)(zr + 2688);
                const size_t oo = ((size_t)((bd * 128 + (j - 4)) * 2 + kvh)) * 64 + piece * 8;
                *(f32x4*)(p.out + O_SSK + oo) = (f32x4){bflo(kq.x), bfhi(kq.x), bflo(kq.y), bfhi(kq.y)}; *(f32x4*)(p.out + O_SSK + oo + 4) = (f32x4){bflo(kq.z), bfhi(kq.z), bflo(kq.w), bfhi(kq.w)};
                *(f32x4*)(p.out + O_SSV + oo) = (f32x4){bflo(vq.x), bfhi(vq.x), bflo(vq.y), bfhi(vq.y)}; *(f32x4*)(p.out + O_SSV + oo + 4) = (f32x4){bflo(vq.z), bfhi(vq.z), bflo(vq.w), bfhi(vq.w)}; }
            *(LAS v4u*)(sK + j * 72 + piece * 8) = kq; *(LAS v4u*)(sV + j * 72 + piece * 8) = vq; } }
    __syncthreads();
    if (wave == 0) {
        const int sq = r16 >> 2, g = r16 & 3, hh = kvh * 4 + g; const bf16* qp = Z + (size_t)(row0 + sq) * ZW + 2048 + hh * 64 + 8 * quad;
        const bf16x8 qf0 = *(const bf16x8*)qp, qf1 = *(const bf16x8*)(qp + 32);
        f32x4 s[10];
#pragma unroll
        for (int kt = 0; kt < 10; ++kt) { const LAS bf16* kp = sK + (16 * kt + r16) * 72 + 8 * quad; const bf16x8 k0 = *(const LAS bf16x8*)kp, k1 = *(const LAS bf16x8*)(kp + 32);
            s[kt] = MFMA16(k0, qf0, ((f32x4){0.f, 0.f, 0.f, 0.f})); s[kt] = MFMA16(k1, qf1, s[kt]); }
        const float slope = __uint_as_float((unsigned)(126 - hh) << 23)  , sink = p.in[14][hh]; float mx = sink;
#pragma unroll
        for (int kt = 0; kt < 10; ++kt)
#pragma unroll
            for (int rg = 0; rg < 4; ++rg) { const int j = 16 * kt + 4 * quad + rg; const int dist = 128 + sq - j; const bool valid = dist >= 0 && dist < 128;
                const float v = valid ? s[kt][rg] - slope * (float)dist : -INFINITY; s[kt][rg] = v; mx = fmaxf(mx, v); }
        mx = fmaxf(mx, __shfl_xor(mx, 16)); mx = fmaxf(mx, __shfl_xor(mx, 32));
        float sum = 0.f;
#pragma unroll
        for (int kt = 0; kt < 10; ++kt)
#pragma unroll
            for (int rg = 0; rg < 4; ++rg) { const float e = __expf(s[kt][rg] - mx); s[kt][rg] = e; sum += e; }
        sum += __shfl_xor(sum, 16); sum += __shfl_xor(sum, 32);
        const float inv = __builtin_amdgcn_rcpf(sum + __expf(sink - mx));
        f32x4 o[4];
#pragma unroll
        for (int nd = 0; nd < 4; ++nd) o[nd] = (f32x4){0.f, 0.f, 0.f, 0.f};
#pragma unroll
        for (int i2 = 0; i2 < 5; ++i2) { const bf16x8 pa = pack8(s[2 * i2], s[2 * i2 + 1]);
#pragma unroll
            for (int nd = 0; nd < 4; ++nd) { const LAS bf16* vp = sV + (32 * i2 + 4 * quad + ((lane & 15) >> 2)) * 72 + 16 * nd + 4 * (lane & 3);
                const bf16x8 vb = tr_frag(vp, vp + 16 * 72); o[nd] = MFMA16(pa, vb, o[nd]); } }
#pragma unroll
        for (int rg = 0; rg < 4; ++rg) { const int rq = 4 * quad + rg; const float iv = __shfl(inv, rq); const int so = rq >> 2, go = rq & 3;
#pragma unroll
            for (int nd = 0; nd < 4; ++nd) U[(size_t)(row0 + so) * DM + 512 + (kvh * 4 + go) * 64 + 16 * nd + r16] = (bf16)f2bf(o[nd][rg] * iv); }
    }
    __syncthreads();
}

__device__ __forceinline__ void mlstm_sample_item(const Params& p, LAS unsigned char* L, int item) {
    const int tid = tid_fresh(), lane = tid & 63, wave = tid >> 6; const int bd = item >> 2, h = item & 3; const int row0 = NP + bd * 4;
    LAS float* sq = (LAS float*)L;
    LAS float* sk = sq + 512; LAS float* sv = sq + 1024; LAS float* sn = sq + 1536;
    LAS float* sQK = sq + 1664;
    LAS float* sQN = sq + 1680;
    LAS float* sSS = sq + 1688;
    LAS float* sPart = sq + 1792;
    const bf16* Z = (const bf16*)(p.ws + WS_HZ); bf16* U = (bf16*)(p.ws + WS_XN); const float* GA = (const float*)(p.ws + WS_GATES);
    float cin[32]; { const int v = tid & 127, ks = tid >> 7; const float* Cin = p.in[4] + ((size_t)(bd * 4 + h) << 14);
#pragma unroll
        for (int kk = 0; kk < 32; ++kk) cin[kk] = __builtin_nontemporal_load(&Cin[(ks * 32 + kk) * 128 + v]); }
    const float og_pre = bf2f(Z[(size_t)(row0 + (tid >> 7)) * ZW + 1536 + h * 128 + (tid & 127)]);
    for (int idx = tid; idx < 1536; idx += 512) { const int w = idx >> 9, r = idx & 511, t = r >> 7, d = r & 127; sq[idx] = bf2f(Z[(size_t)(row0 + t) * ZW + w * 512 + h * 128 + d]); }
    if (tid < 128) sn[tid] = p.in[5][(size_t)(bd * 4 + h) * 128 + tid];
    float ig[4], bc[4]; { float a = 0.f;
#pragma unroll
        for (int s = 0; s < 4; ++s) { ig[s] = GA[(size_t)(row0 + s) * 8 + h]; a += logsig(GA[(size_t)(row0 + s) * 8 + 4 + h]); bc[s] = a; } }
    const float m0 = p.in[6][bd * 4 + h];
    float mt[4], at[4], W[4][4];
#pragma unroll
    for (int t = 0; t < 4; ++t) { float md = -INFINITY;
#pragma unroll
        for (int s = 0; s <= t; ++s) md = fmaxf(md, bc[t] - bc[s] + ig[s]);
        mt[t] = fmaxf(bc[t] + m0, md); at[t] = __expf(bc[t] + m0 - mt[t]);
#pragma unroll
        for (int s = 0; s < 4; ++s) W[t][s] = s <= t ? __expf(bc[t] - bc[s] + ig[s] - mt[t]) : 0.f; }
    const float bL = bc[3]; float mnew = bL + m0; float wk[4];
#pragma unroll
    for (int s = 0; s < 4; ++s) mnew = fmaxf(mnew, bL - bc[s] + ig[s]);
    const float decay = __expf(bL + m0 - mnew);
#pragma unroll
    for (int s = 0; s < 4; ++s) wk[s] = __expf(bL - bc[s] + ig[s] - mnew);
    __syncthreads();
#pragma unroll
    for (int i = 0; i < 2; ++i) { const int pr = wave * 2 + i, t = pr >> 2, s = pr & 3; const float a = wave_sum(sq[t * 128 + lane] * sk[s * 128 + lane] + sq[t * 128 + 64 + lane] * sk[s * 128 + 64 + lane]); if (lane == 0) sQK[pr] = a; }
    if (wave < 4) { const float a = wave_sum(sq[wave * 128 + lane] * sn[lane] + sq[wave * 128 + 64 + lane] * sn[64 + lane]); if (lane == 0) sQN[wave] = a; }
    { const int v = tid & 127, ks = tid >> 7; const float* Cin = p.in[4] + ((size_t)(bd * 4 + h) << 14); float* Cout = p.out + O_SC + ((size_t)(bd * 4 + h) << 14);
        const float v0 = sv[v], v1 = sv[128 + v], v2 = sv[256 + v], v3 = sv[384 + v];
        float a0 = 0.f, a1 = 0.f, a2 = 0.f, a3 = 0.f;
#pragma unroll
        for (int kk = 0; kk < 32; ++kk) { const int k = ks * 32 + kk; const float c = cin[kk];
            a0 += sq[k] * c; a1 += sq[128 + k] * c; a2 += sq[256 + k] * c; a3 += sq[384 + k] * c;
            __builtin_nontemporal_store(decay * c + (wk[0] * sk[k] * v0 + wk[1] * sk[128 + k] * v1) + (wk[2] * sk[256 + k] * v2 + wk[3] * sk[384 + k] * v3), &Cout[k * 128 + v]); }
        sPart[(ks * 4 + 0) * 128 + v] = a0; sPart[(ks * 4 + 1) * 128 + v] = a1; sPart[(ks * 4 + 2) * 128 + v] = a2; sPart[(ks * 4 + 3) * 128 + v] = a3; }
    if (tid < 128) p.out[O_SN + (size_t)(bd * 4 + h) * 128 + tid] = decay * sn[tid] + (wk[0] * sk[tid] + wk[1] * sk[128 + tid]) + (wk[2] * sk[256 + tid] + wk[3] * sk[384 + tid]);
    if (tid == 0) p.out[O_SM + bd * 4 + h] = mnew;
    __syncthreads();
    { const int t = tid >> 7, v = tid & 127; const float qc = (sPart[(0 * 4 + t) * 128 + v] + sPart[(1 * 4 + t) * 128 + v]) + (sPart[(2 * 4 + t) * 128 + v] + sPart[(3 * 4 + t) * 128 + v]);
        float att = 0.f, mtt = 0.f, num, den; float S[4];
#pragma unroll
        for (int tt = 0; tt < 4; ++tt) if (tt == t) { att = at[tt]; mtt = mt[tt];
#pragma unroll
            for (int s = 0; s < 4; ++s) S[s] = sQK[tt * 4 + s] * W[tt][s]; }
        num = att * qc + (S[0] * sv[v] + S[1] * sv[128 + v]) + (S[2] * sv[256 + v] + S[3] * sv[384 + v]);
        den = att * sQN[t] + (S[0] + S[1]) + (S[2] + S[3]);
        const float hv = num * __builtin_amdgcn_rcpf(fmaxf(fabsf(den), __expf(-mtt)));
        const float q2 = wave_sum(hv * hv); if (lane == 0) sSS[wave] = q2;
        __syncthreads();
        const float ss = sSS[2 * t] + sSS[2 * t + 1]; const float rn = __builtin_amdgcn_rsqf(ss * (1.f / 128.f) + EPS);
        const float og = og_pre; const float sg = __builtin_amdgcn_rcpf(1.0f + __expf(-og));
        U[(size_t)(row0 + t) * DM + h * 128 + v] = (bf16)f2bf(hv * rn * p.in[13][h * 128 + v] * sg); }
    __syncthreads();
}

__device__ __forceinline__ void scan_phase(const Params& p, LAS unsigned char* L) {
    const int tid = tid_fresh(), lane = tid & 63, wave = tid >> 6;
    if (tid < 256) {
        for (int gid = blockIdx.x * 256 + tid; gid < 65536; gid += gridDim.x * 256) {
            const int bh = gid >> 13, dv = (gid & 8191) >> 6, dk = (gid & 63) * 2; unsigned* q = (unsigned*)((bf16*)(p.ws + WS_CT) + ((size_t)(bh * 128 + dv) << 12) + dk); const f32x4* dec4 = (const f32x4*)((const float*)(p.ws + WS_DEC) + bh * 128);
            float C0 = 0.f, C1 = 0.f; unsigned d[32]; float dc[32];
#pragma unroll
            for (int u = 0; u < 32; ++u) { d[u] = q[u * 64]; const f32x4 t = dec4[u]; dc[u] = (t[0] * t[1]) * (t[2] * t[3]); }
#pragma unroll
            for (int u = 0; u < 32; ++u) { q[u * 64] = pk2(C0, C1); C0 = dc[u] * C0 + bflo(d[u]); C1 = dc[u] * C1 + bfhi(d[u]); }
            float* pc = p.out + O_PC + ((size_t)bh << 14); pc[dk * 128 + dv] = C0; pc[(dk + 1) * 128 + dv] = C1; }
    } else if (wave == 4) {
        for (int idx = blockIdx.x * 64 + lane; idx < 1024; idx += gridDim.x * 64) { const int bh = idx >> 7, dk = idx & 127; float* q = (float*)(p.ws + WS_NB) + ((size_t)(bh * 32) << 7) + dk; const f32x4* dec4 = (const f32x4*)((const float*)(p.ws + WS_DEC) + bh * 128);
            float n = 0.f; float d[32], dc[32];
#pragma unroll
            for (int u = 0; u < 32; ++u) { d[u] = q[u * 128]; const f32x4 t = dec4[u]; dc[u] = (t[0] * t[1]) * (t[2] * t[3]); }
#pragma unroll
            for (int u = 0; u < 32; ++u) { q[u * 128] = n; n = dc[u] * n + d[u]; }
            p.out[O_PN + idx] = n; }
    }
    { LAS float* scr = (LAS float*)(L + wave * 16384);
        if (wave >= 5) { for (int it = blockIdx.x * 3 + (wave - 5); it < 1536; it += gridDim.x * 3) { if (it < 1408) conv_item(p, scr, lane, 4, it); else conv_item(p, scr, lane, 5, it - 1408); } }
        else { for (int it = 1536 + blockIdx.x * 5 + wave; it < 2816; it += gridDim.x * 5) conv_item(p, scr, lane, 5, it - 1408); } }
}

__device__ __forceinline__ void mlstm_out_phase(const Params& p, LAS unsigned char* L) {
    const int tid = tid_fresh(), lane = tid & 63, wave = tid >> 6, r16 = lane & 15, quad = lane >> 4;
    LAS bf16* sQ = (LAS bf16*)L; LAS bf16* sK = (LAS bf16*)(L + 17408); LAS bf16* sVT = (LAS bf16*)(L + 34816); LAS bf16* sCT = (LAS bf16*)(L + 53248);
    LAS float* sN = (LAS float*)(L + 88064); LAS float* sAl = sN + 128; LAS float* sBe = sAl + 64; LAS float* sA = sBe + 64; LAS float* sEm = sA + 64; LAS float* sQN = sEm + 64; LAS float* sSS = sQN + 64;
    LAS float* sWK = sSS + 128; LAS bf16* sVw = (LAS bf16*)(L + 90624);
    const bf16* Z = (const bf16*)(p.ws + WS_HZ); bf16* U = (bf16*)(p.ws + WS_XN);
    const int trq = (lane & 15) >> 2, trp = lane & 3;
    for (int unit = blockIdx.x; unit < 256; unit += gridDim.x) {
    const int bh = unit >> 5, sc = unit & 31, b = bh >> 2, h = bh & 3;
    { const bf16* ctg = (const bf16*)(p.ws + WS_CT) + ((size_t)(bh * 128) << 12) + ((size_t)sc << 7);
#pragma unroll
        for (int i = 0; i < 4; ++i) { const int pc = tid + 512 * i, dv = pc >> 4, piece = pc & 15; *(LAS v4u*)(sCT + dv * 136 + piece * 8) = *(const v4u*)(ctg + ((size_t)dv << 12) + piece * 8); } }
    if (tid < 128) sN[tid] = ((const float*)(p.ws + WS_NB))[(size_t)(bh * 32 + sc) * 128 + tid];
    __syncthreads();
    f32x4 cst[8];
#pragma unroll
    for (int mi = 0; mi < 8; ++mi) { const v2u w = *(const LAS v2u*)(sCT + (16 * wave + r16) * 136 + 16 * mi + 4 * quad); cst[mi] = (f32x4){bflo(w.x), bfhi(w.x), bflo(w.y), bfhi(w.y)}; }
    v4u nq[2], nk[2], nv[2]; float nig = 0.f, nfg = 0.f;
#define OUT_LOAD(CH) do { const int row0_ = b * 8192 + (CH) * 64; \
        _Pragma("unroll") for (int i = 0; i < 2; ++i) { const int pc = tid + 512 * i, t = pc >> 4, piece = pc & 15; const bf16* zr = Z + (size_t)(row0_ + t) * ZW + h * 128 + piece * 8; nq[i] = *(const v4u*)zr; nk[i] = *(const v4u*)(zr + 512); nv[i] = *(const v4u*)(zr + 1024); } \
        if (wave == 0) { const size_t row = (size_t)row0_ + lane; nig = ((const float*)(p.ws + WS_GATES))[row * 8 + h]; nfg = ((const float*)(p.ws + WS_GATES))[row * 8 + 4 + h]; } } while (0)
    OUT_LOAD(4 * sc);
    for (int j = 0; j < 4; ++j) {
    const int ch = 4 * sc + j; const int row0 = b * 8192 + ch * 64;
    if (wave == 0) { const float ig = nig, fg = nfg; const float bc = scan_sum(logsig(fg), lane); const float be = ig - bc; const float pm = scan_max(be, lane);
        const float mc = ((const float*)(p.ws + WS_MST))[bh * 132 + ch]; const float mt = bc + fmaxf(mc, pm);
        sAl[lane] = bc - mt; sBe[lane] = be; sA[lane] = __expf(bc + mc - mt); sEm[lane] = __expf(-mt);
        const float bL = RDL_F(bc, 63); sWK[lane] = __expf(bL + be - ((const float*)(p.ws + WS_MST))[bh * 132 + ch + 1]); }
#pragma unroll
    for (int i = 0; i < 2; ++i) { const int pc = tid + 512 * i, t = pc >> 4, piece = pc & 15;
        *(LAS v4u*)(sQ + t * 136 + piece * 8) = nq[i]; *(LAS v4u*)(sK + t * 136 + piece * 8) = nk[i];
        *(LAS v4u*)(sVT + t * 144 + piece * 8) = nv[i]; }
    __syncthreads();
    if (j < 3) OUT_LOAD(ch + 1);
    __builtin_amdgcn_sched_barrier(0);
    if (j < 3) {
#pragma unroll
        for (int i = 0; i < 2; ++i) { const int pc = tid + 512 * i, t = pc >> 4, piece = pc & 15; const float wk = sWK[t]; const v4u v4 = *(const LAS v4u*)(sVT + t * 144 + piece * 8); v4u o;
#pragma unroll
            for (int w = 0; w < 4; ++w) o[w] = pk2(bflo(v4[w]) * wk, bfhi(v4[w]) * wk);
            *(LAS v4u*)(sVw + t * 144 + piece * 8) = o; } }
    { const int t = tid >> 3, part = tid & 7; float s = 0.f;
#pragma unroll
        for (int e = 0; e < 16; ++e) s += bf2f(sQ[t * 136 + part * 16 + e]) * sN[part * 16 + e];
        s = row8_sum(s); if (part == 0) sQN[t] = s; }
    __syncthreads();
    const int tt = wave & 3, dh = wave >> 2;
    unsigned short ogr[4][4];
#pragma unroll
    for (int rg = 0; rg < 4; ++rg)
#pragma unroll
        for (int nv = 0; nv < 4; ++nv) ogr[rg][nv] = Z[(size_t)(row0 + 16 * tt + 4 * quad + rg) * ZW + 1536 + h * 128 + 16 * (4 * dh + nv) + r16];
    bf16x8 qf[4];
#pragma unroll
    for (int kk = 0; kk < 4; ++kk) qf[kk] = *(const LAS bf16x8*)(sQ + (16 * tt + r16) * 136 + 8 * quad + 32 * kk);
    f32x4 sT[4];
#pragma unroll
    for (int mi = 0; mi < 4; ++mi) { sT[mi] = (f32x4){0.f, 0.f, 0.f, 0.f};
#pragma unroll
        for (int kk = 0; kk < 4; ++kk) { const bf16x8 kf = *(const LAS bf16x8*)(sK + (16 * mi + r16) * 136 + 8 * quad + 32 * kk); sT[mi] = MFMA16(kf, qf[kk], sT[mi]); } }
    const int tl = 16 * tt + r16; const float al = sAl[tl]; float rs = 0.f;
#pragma unroll
    for (int mi = 0; mi < 4; ++mi)
#pragma unroll
        for (int rg = 0; rg < 4; ++rg) { const int si = 16 * mi + 4 * quad + rg; const float w = si <= tl ? __expf(al + sBe[si]) : 0.f; const float v = sT[mi][rg] * w; sT[mi][rg] = v; rs += v; }
    rs += __shfl_xor(rs, 16); rs += __shfl_xor(rs, 32);
    const float den = sA[tl] * sQN[tl] + rs; const float inv = __builtin_amdgcn_rcpf(fmaxf(fabsf(den), sEm[tl]));
    bf16x8 pa[2]; pa[0] = pack8(sT[0], sT[1]); pa[1] = pack8(sT[2], sT[3]);
    f32x4 acc[4];
#pragma unroll
    for (int nv = 0; nv < 4; ++nv) { acc[nv] = (f32x4){0.f, 0.f, 0.f, 0.f}; const int dvb = 16 * (4 * dh + nv) + r16;
#pragma unroll
        for (int kk = 0; kk < 4; ++kk) { const bf16x8 cf = *(const LAS bf16x8*)(sCT + dvb * 136 + 8 * quad + 32 * kk); acc[nv] = MFMA16(qf[kk], cf, acc[nv]); } }
#pragma unroll
    for (int rg = 0; rg < 4; ++rg) { const float ar = sA[16 * tt + 4 * quad + rg];
#pragma unroll
        for (int nv = 0; nv < 4; ++nv) acc[nv][rg] *= ar; }
#pragma unroll
    for (int i2 = 0; i2 < 2; ++i2)
#pragma unroll
        for (int nv = 0; nv < 4; ++nv) { const LAS bf16* vp = sVT + (32 * i2 + 4 * quad + ((lane & 15) >> 2)) * 144 + 16 * (4 * dh + nv) + 4 * (lane & 3);
            const bf16x8 vb = tr_frag(vp, vp + 16 * 144); acc[nv] = MFMA16(pa[i2], vb, acc[nv]); }
#pragma unroll
    for (int rg = 0; rg < 4; ++rg) { const float iv = __shfl(inv, 4 * quad + rg); float q2 = 0.f;
#pragma unroll
        for (int nv = 0; nv < 4; ++nv) { acc[nv][rg] *= iv; q2 += acc[nv][rg] * acc[nv][rg]; }
        q2 = row16_sum(q2);
        if (r16 == 0) sSS[dh * 64 + 16 * tt + 4 * quad + rg] = q2; }
    __syncthreads();
    if (j < 3) {
        const float dec = ((const float*)(p.ws + WS_DEC))[bh * 128 + ch];
#pragma unroll
        for (int mi = 0; mi < 8; ++mi) cst[mi] = cst[mi] * dec;
#pragma unroll
        for (int kk = 0; kk < 2; ++kk) { const int rw = 32 * kk + 8 * quad + trq; const bf16x8 bfr = tr_frag(sVw + rw * 144 + 4 * trp + 16 * wave, sVw + (rw + 4) * 144 + 4 * trp + 16 * wave);
#pragma unroll
            for (int mi = 0; mi < 8; ++mi) { const bf16x8 afr = tr_frag(sK + rw * 136 + 4 * trp + 16 * mi, sK + (rw + 4) * 136 + 4 * trp + 16 * mi); cst[mi] = MFMA16(afr, bfr, cst[mi]); } }
#pragma unroll
        for (int mi = 0; mi < 8; ++mi) { v2u o; o.x = pk2_sw(cst[mi][0], cst[mi][1]); o.y = pk2_sw(cst[mi][2], cst[mi][3]); *(LAS v2u*)(sCT + (16 * wave + r16) * 136 + 16 * mi + 4 * quad) = o; }
        if (tid < 128) { float s = 0.f;
#pragma unroll 8
            for (int t = 0; t < 64; ++t) s += bf2f(sK[t * 136 + tid]) * sWK[t];
            sN[tid] = dec * sN[tid] + s; } }
#pragma unroll
    for (int rg = 0; rg < 4; ++rg) { const int to = 16 * tt + 4 * quad + rg; const float rn = __builtin_amdgcn_rsqf((sSS[to] + sSS[64 + to]) * (1.f / 128.f) + EPS);
#pragma unroll
        for (int nv = 0; nv < 4; ++nv) { const int dv = 16 * (4 * dh + nv) + r16; const float og = bf2f(ogr[rg][nv]); const float sg = __builtin_amdgcn_rcpf(1.0f + __expf(-og));
            U[(size_t)(row0 + to) * DM + h * 128 + dv] = (bf16)f2bf(acc[nv][rg] * rn * p.in[13][h * 128 + dv] * sg); } }
    __syncthreads();
    }
#undef OUT_LOAD
    }
}

template <int K>
__device__ __forceinline__ void sample_gemm_piece(LAS unsigned char* L, const bf16* A, const bf16* Bt, bf16* Yo, int piece) {
    const int tid = tid_fresh(), lane = tid & 63, wave = tid >> 6, r16 = lane & 15, quad = lane >> 4;
    const int mrow0 = (piece >> 4) * 32, ncol0 = (piece & 15) * 64; constexpr int KW = K / 8, NK = KW / 32;
    f32x4 acc[2][4];
#pragma unroll
    for (int mi = 0; mi < 2; ++mi)
#pragma unroll
        for (int ni = 0; ni < 4; ++ni) acc[mi][ni] = (f32x4){0.f, 0.f, 0.f, 0.f};
    const bf16* ap = A + (size_t)(mrow0 + r16) * K + wave * KW + 8 * quad; const bf16* bp = Bt + (size_t)(ncol0 + r16) * K + wave * KW + 8 * quad;
#pragma unroll
    for (int ks = 0; ks < NK; ++ks) { bf16x8 a[2], b[4];
#pragma unroll
        for (int mi = 0; mi < 2; ++mi) a[mi] = *(const bf16x8*)(ap + (size_t)(16 * mi) * K + 32 * ks);
#pragma unroll
        for (int ni = 0; ni < 4; ++ni) b[ni] = *(const bf16x8*)(bp + (size_t)(16 * ni) * K + 32 * ks);
#pragma unroll
        for (int mi = 0; mi < 2; ++mi)
#pragma unroll
            for (int ni = 0; ni < 4; ++ni) acc[mi][ni] = MFMA16(a[mi], b[ni], acc[mi][ni]); }
    LAS float* red = (LAS float*)L + wave * 2048;
#pragma unroll
    for (int mi = 0; mi < 2; ++mi)
#pragma unroll
        for (int ni = 0; ni < 4; ++ni)
#pragma unroll
            for (int rg = 0; rg < 4; ++rg) red[(16 * mi + 4 * quad + rg) * 64 + 16 * ni + r16] = acc[mi][ni][rg];
    __syncthreads();
    { const int row = tid >> 4, c4 = (tid & 15) * 4; f32x4 s = {0.f, 0.f, 0.f, 0.f};
#pragma unroll
        for (int w = 0; w < 8; ++w) s += *(const LAS f32x4*)((LAS float*)L + w * 2048 + row * 64 + c4);
        v2u o; o.x = pk2(s[0], s[1]); o.y = pk2(s[2], s[3]); *(v2u*)(Yo + (size_t)(mrow0 + row) * DM + ncol0 + c4) = o; }
    __syncthreads();
}

template <class Epi>
__device__ __forceinline__ void run_gemm(LAS unsigned char* L, const bf16* A, const bf16* Bt, int M, int N, int K, const Epi& E) {
    pg8::Gemm g{A, Bt, M, N, K}; pg8::StaticOrder S; S.init(M, N, (int)gridDim.x, (int)blockIdx.x);
    pg8::gemm_phase<Epi, pg8::StaticOrder, true, true>((PG8_LAS unsigned char*)L, g, S, E);
}

__global__ void __launch_bounds__(512, 2) fwd_megakernel(Params p) {
    extern __shared__ __attribute__((aligned(16))) unsigned char lds_raw[];
    LAS unsigned char* L = (LAS unsigned char*)lds_raw;
    cg::grid_group grid = cg::this_grid();
    unsigned char* ws = p.ws;
    bf16* XN = (bf16*)(ws + WS_XN); bf16* HZ = (bf16*)(ws + WS_HZ); bf16* Y = (bf16*)(ws + WS_Y);
    const int G = gridDim.x, bx = blockIdx.x;

    if (threadIdx.x < 8) ((LAS unsigned*)(L + 131072))[threadIdx.x] = 0u;
    __syncthreads();
    const XcdBarrier bar = xcd_barrier_post((unsigned*)(ws + WS_CTL), (volatile LAS unsigned*)(L + 131072));
    if (p.out == nullptr) grid.sync();
    prologue(p, L);
    xcd_barrier(bar);
    { pg8::EpiSwiglu E{HZ, DFF}; run_gemm(L, XN, (const bf16*)(ws + WS_WGU1), NROWS, 2 * DFF, DM, E); }
    { const int rem = 1452 % G; if (rem != 0 && bx >= rem) conv_tail_a(p, L, bx - rem, G - rem); else if (rem == 0) conv_tail_a(p, L, bx, G); }
    xcd_barrier(bar);
    { pg8::EpiBf16<0> E{Y, DM, nullptr, 0, 0, 1.f}; run_gemm(L, HZ, (const bf16*)(ws + WS_WD1), NP, DM, DFF, E); }
    for (int pc = bx; pc < 256; pc += G) sample_gemm_piece<DFF>(L, HZ + (size_t)NP * DFF, (const bf16*)(ws + WS_WD1), Y + (size_t)NP * DM, pc);
    xcd_barrier(bar);
    row_pass<false, false, true>(p, L, 0.5f, 1, 2, XN, (bf16*)p.out, (const float*)(ws + WS_RS) + 2 * NROWS, (float*)(ws + WS_RS));
    xcd_barrier(bar);
    { pg8::EpiBf16<0> E{HZ, ZW, nullptr, 0, 0, 1.f}; run_gemm(L, (const bf16*)p.out, (const bf16*)(ws + WS_WIN), NROWS, ZW, DM, E); }
    if (bx >= G - 8) stats_item(p, L, bx - (G - 8));
    xcd_barrier(bar);
    mlstm_dcs_phase(p, L);
    for (int it = bx; it < 256; it += G) swa_prompt_item(p, L, it);
    for (int it = bx; it < 512; it += G) mlstm_sample_item(p, L, it);
    for (int it = bx; it < 256; it += G) swa_sample_item(p, L, it);
    xcd_barrier(bar);
    scan_phase(p, L);
    xcd_barrier(bar);
    mlstm_out_phase(p, L);
    xcd_barrier(bar);
    { pg8::EpiBf16<0> E{Y, DM, nullptr, 0, 0, 1.f}; run_gemm(L, XN, (const bf16*)(ws + WS_WOUT), NP, DM, DM, E); }
    for (int pc = bx; pc < 256; pc += G) sample_gemm_piece<DM>(L, XN + (size_t)NP * DM, (const bf16*)(ws + WS_WOUT), Y + (size_t)NP * DM, pc);
    xcd_barrier(bar);
    row_pass<false, false, false>(p, L, 1.0f, 3, 4, (const bf16*)p.out, (bf16*)(ws + WS_CT), (const float*)(ws + WS_RS), (float*)(ws + WS_RS) + NROWS);
    xcd_barrier(bar);
    { pg8::EpiSwiglu E{HZ, DFF}; run_gemm(L, (const bf16*)(ws + WS_CT), (const bf16*)(ws + WS_WGU2), NROWS, 2 * DFF, DM, E); }
    xcd_barrier(bar);
    { pg8::EpiBf16<0> E{Y, DM, nullptr, 0, 0, 1.f}; run_gemm(L, HZ, (const bf16*)(ws + WS_WD2), NP, DM, DFF, E); }
    for (int pc = bx; pc < 256; pc += G) sample_gemm_piece<DFF>(L, HZ + (size_t)NP * DFF, (const bf16*)(ws + WS_WD2), Y + (size_t)NP * DM, pc);
    xcd_barrier(bar);
    row_pass<false, true, false>(p, L, 0.5f, 5, 5, (const bf16*)(ws + WS_CT), nullptr, (const float*)(ws + WS_RS) + NROWS, nullptr);
}

extern "C" void kernel_launch(void* const* d_in, const int* in_sizes, int n_in, void* d_out, int out_size, void* d_ws, size_t ws_size, hipStream_t stream) {
    static int grid = 0;
    if (grid == 0) {
        int dev = 0, cus = 0, per_cu = 0;
        hipGetDevice(&dev);
        hipDeviceGetAttribute(&cus, hipDeviceAttributeMultiprocessorCount, dev);
        hipFuncSetAttribute((const void*)fwd_megakernel, hipFuncAttributeMaxDynamicSharedMemorySize, LDS_BYTES);
        hipOccupancyMaxActiveBlocksPerMultiprocessor(&per_cu, (const void*)fwd_megakernel, 512, LDS_BYTES);
        if (per_cu < 1) { fprintf(stderr, "kernel_launch: occupancy query returned %d\n", per_cu); per_cu = 1; }
        (void)hipGetLastError();
        grid = cus * 1;
        if (n_in != 16 || ws_size < 240 * MiB) fprintf(stderr, "kernel_launch: unexpected n_in %d / ws %zu\n", n_in, ws_size);
    }
    Params p{};
    for (int i = 0; i < 16; ++i) p.in[i] = (const float*)d_in[i];
    p.out = (float*)d_out; p.ws = (unsigned char*)d_ws;
    (void)hipMemsetAsync((unsigned char*)d_ws + WS_CTL, 0, 16384, stream);
    void* args[] = {&p};
    hipError_t e = hipLaunchCooperativeKernel((const void*)fwd_megakernel, dim3(grid), dim3(512), args, LDS_BYTES, stream);
    if (e != hipSuccess) fprintf(stderr, "cooperative launch failed: %s (grid %d)\n", hipGetErrorString(e), grid);
}
```
